# Optimizing an MI355X kernel written in HIP

```python
import jax, jax.numpy as jnp
from jax import lax
import numpy as np

D_MODEL = 4096
BATCH = 4
SEQ = 2048
DEPTH = 4

CHUNK = 64
N_MIXERS = 3
ROPE_THETA = 10000.0
NORM_EPS = 1e-6
D_FF = 6144
FFN_RES = 0.5
MLA_HEADS = 32
MLA_Q_LORA = 1024
MLA_KV_LORA = 512
MLA_NOPE = 128
MLA_ROPE = 64
MLA_V = 128
ATTN_Q_BLOCK = 128
DSA_HEADS = 32
DSA_KV_HEADS = 8
DSA_HEAD_DIM = 128
IDX_HEADS = 32
IDX_DIM = 128
IDX_ROPE = 64
DSA_TOPK_MAX = 256
RWKV_HEAD = 64
RWKV_HEADS = D_MODEL // RWKV_HEAD
DECAY_LORA = 128
AAA_LORA = 128
GATE_LORA = 480
GN_EPS = 64e-5

kernel_name = 'hybrid_mla_dsa_rwkv7_macaron'


def rms_norm(x, g):
    xf = x.astype(jnp.float32)
    y = xf * lax.rsqrt(jnp.mean(xf * xf, axis=-1, keepdims=True) + NORM_EPS)
    return (y * g.astype(jnp.float32)).astype(x.dtype)


def rope(x, pos):
    d = x.shape[-1]
    inv = jnp.power(ROPE_THETA, -jnp.arange(0, d, 2, dtype=jnp.float32) / d)
    ang = pos.astype(jnp.float32)[..., None] * inv
    ang = ang.reshape(ang.shape[:2] + (1,) * (x.ndim - 3) + (d // 2,))
    cos, sin = jnp.cos(ang), jnp.sin(ang)
    xf = x.astype(jnp.float32)
    x1, x2 = xf[..., : d // 2], xf[..., d // 2:]
    return jnp.concatenate([x1 * cos - x2 * sin, x2 * cos + x1 * sin], axis=-1).astype(x.dtype)


def swiglu(h, w_gu, w_down):
    gate, up = jnp.split(h @ w_gu, 2, axis=-1)
    return (jax.nn.silu(gate) * up) @ w_down


def mla_mixer(h, pos, w_in, q_norm, w_uq, kv_norm, w_ukv, w_o):
    B, T, _ = h.shape
    lat = h @ w_in
    c_q, c_kv, k_rope = jnp.split(lat, [MLA_Q_LORA, MLA_Q_LORA + MLA_KV_LORA], axis=-1)
    q = (rms_norm(c_q, q_norm) @ w_uq).reshape(B, T, MLA_HEADS, MLA_NOPE + MLA_ROPE)
    q_nope, q_rope = q[..., :MLA_NOPE], rope(q[..., MLA_NOPE:], pos)
    k_rope = rope(k_rope, pos)
    kv = (rms_norm(c_kv, kv_norm) @ w_ukv).reshape(B, T, MLA_HEADS, MLA_NOPE + MLA_V)
    k_nope, v = kv[..., :MLA_NOPE], kv[..., MLA_NOPE:]
    scale = (MLA_NOPE + MLA_ROPE) ** -0.5
    outs = []
    for start in range(0, T, ATTN_Q_BLOCK):
        end = start + ATTN_Q_BLOCK
        s = (jnp.einsum('bqhd,bkhd->bhqk', q_nope[:, start:end], k_nope[:, :end])
             + jnp.einsum('bqhr,bkr->bhqk', q_rope[:, start:end], k_rope[:, :end]))
        s = s.astype(jnp.float32) * scale
        q_chunk = np.arange(start, end) // CHUNK
        k_chunk = np.arange(end) // CHUNK
        s = jnp.where(k_chunk[None, :] <= q_chunk[:, None], s, -jnp.inf)
        p = jax.nn.softmax(s, axis=-1).astype(v.dtype)
        outs.append(jnp.einsum('bhqk,bkhd->bqhd', p, v[:, :end]))
    o = jnp.concatenate(outs, axis=1).reshape(B, T, MLA_HEADS * MLA_V)
    return o @ w_o


def dsa_mixer(h, pos, w_in, w_o):
    B, T, _ = h.shape
    G, HD = DSA_KV_HEADS, DSA_HEAD_DIM
    rep = DSA_HEADS // G
    topk = min(DSA_TOPK_MAX, T // 4)
    sizes = [DSA_HEADS * HD, G * HD, G * HD, IDX_HEADS * IDX_DIM, IDX_DIM]
    splits = [int(s) for s in np.cumsum(sizes)]
    q, k, v, qi, ki, wi = jnp.split(h @ w_in, splits, axis=-1)
    q = rope(q.reshape(B, T, DSA_HEADS, HD), pos)
    k = rope(k.reshape(B, T, G, HD), pos)
    v = v.reshape(B, T, G, HD)
    qi = qi.reshape(B, T, IDX_HEADS, IDX_DIM)
    qi = jnp.concatenate([rope(qi[..., :IDX_ROPE], pos), qi[..., IDX_ROPE:]], axis=-1)
    ki = jnp.concatenate([rope(ki[..., :IDX_ROPE], pos), ki[..., IDX_ROPE:]], axis=-1)
    wi = wi * (IDX_HEADS ** -0.5 * IDX_DIM ** -0.5)
    key_chunk = jnp.arange(T) // CHUNK
    gather = jax.vmap(lambda a, i: a[i])

    def chunk_attn(c):
        st = c * CHUNK
        qi_c = lax.dynamic_slice_in_dim(qi, st, CHUNK, axis=1)
        wi_c = lax.dynamic_slice_in_dim(wi, st, CHUNK, axis=1)
        q_c = lax.dynamic_slice_in_dim(q, st, CHUNK, axis=1)
        dots = jax.nn.relu(jnp.einsum('bqhd,bsd->bqhs', qi_c, ki))
        score = jnp.einsum('bqh,bqhs->bqs', wi_c, dots).astype(jnp.float32)
        score = jnp.where((key_chunk <= c)[None, None, :], score, -jnp.inf)
        _, idx = lax.top_k(score, topk)
        valid = idx < (c + 1) * CHUNK
        k_sel = gather(k, idx)
        v_sel = gather(v, idx)
        qg = q_c.reshape(B, CHUNK, G, rep, HD)
        s = jnp.einsum('bqgrd,bqkgd->bqgrk', qg, k_sel).astype(jnp.float32) * HD ** -0.5
        s = jnp.where(valid[:, :, None, None, :], s, -jnp.inf)
        p = jax.nn.softmax(s, axis=-1).astype(v.dtype)
        o = jnp.einsum('bqgrk,bqkgd->bqgrd', p, v_sel)
        return o.reshape(B, CHUNK, DSA_HEADS * HD)

    o = lax.map(chunk_attn, jnp.arange(T // CHUNK))
    o = jnp.moveaxis(o, 0, 1).reshape(B, T, DSA_HEADS * HD)
    return o @ w_o


def wkv7_scan(r, w, k, v, a, b):
    B, T, H, N = r.shape

    def step(S, inp):
        r_t, w_t, k_t, v_t, a_t, b_t = inp
        sa = jnp.einsum('bhvk,bhk->bhv', S, a_t)
        S = (S * w_t[:, :, None, :] + sa[..., None] * b_t[:, :, None, :]
             + v_t[..., None] * k_t[:, :, None, :])
        return S, jnp.einsum('bhvk,bhk->bhv', S, r_t)

    xs = tuple(jnp.moveaxis(t.astype(jnp.float32), 1, 0) for t in (r, w, k, v, a, b))
    S0 = jnp.zeros((B, H, N, N), jnp.float32)
    _, y = lax.scan(step, S0, xs)
    return jnp.moveaxis(y, 0, 1)


def rwkv7_mixer(h, mu, w_r, w_k, w_v, w_o, w0, w1, w2, a0, a1, a2, g1, g2,
                k_k, k_a, r_k, lnx_w, lnx_b):
    B, T, C = h.shape
    H, N = RWKV_HEADS, RWKV_HEAD
    heads = lambda t: t.reshape(B, T, H, N)
    xx = jnp.pad(h, ((0, 0), (1, 0), (0, 0)))[:, :-1] - h
    mu_r, mu_w, mu_k, mu_v, mu_a, mu_g = mu
    xr, xw, xk = h + xx * mu_r, h + xx * mu_w, h + xx * mu_k
    xv, xa, xg = h + xx * mu_v, h + xx * mu_a, h + xx * mu_g
    r = xr @ w_r
    w_log = -jax.nn.softplus(-(w0 + jnp.tanh(xw @ w1) @ w2)) - 0.5
    k = xk @ w_k
    v = xv @ w_v
    a = jax.nn.sigmoid(a0 + (xa @ a1) @ a2)
    g = jax.nn.sigmoid(xg @ g1) @ g2
    kk = heads(k * k_k).astype(jnp.float32)
    kk = kk / jnp.maximum(jnp.sqrt(jnp.sum(kk * kk, axis=-1, keepdims=True)), 1e-12)
    k = k * (1 + (a - 1) * k_a)
    decay = jnp.exp(-jnp.exp(w_log.astype(jnp.float32)))
    y = wkv7_scan(heads(r), heads(decay), heads(k), heads(v), -kk,
                  kk * heads(a).astype(jnp.float32))
    mean = jnp.mean(y, axis=-1, keepdims=True)
    var = jnp.mean(jnp.square(y - mean), axis=-1, keepdims=True)
    y = ((y - mean) * lax.rsqrt(var + GN_EPS)).reshape(B, T, C) * lnx_w + lnx_b
    bonus = jnp.sum(heads(r) * heads(k) * r_k, axis=-1, keepdims=True) * heads(v)
    y = y + bonus.reshape(B, T, C)
    return (y * g).astype(h.dtype) @ w_o


def setup_inputs(seed: int = 0) -> dict:
    key = jax.random.key(seed)
    ks = list(jax.random.split(key, 96))
    D, F = D_MODEL, D_FF

    def nrm(shape, scale):
        return jax.random.normal(ks.pop(), shape, jnp.float32) * scale

    def gain(shape):
        return 1.0 + nrm(shape, 0.05)

    def ffn_params(i):
        return {'ffn_norm_%d' % i: gain((2, D)),
                'ffn_w_gu_%d' % i: nrm((2, D, 2 * F), D ** -0.5),
                'ffn_w_down_%d' % i: nrm((2, F, D), F ** -0.5),
                'mix_norm_%d' % i: gain((D,))}

    def mla_params(i):
        p = 'mla%d_' % i
        return {p + 'w_in': nrm((D, MLA_Q_LORA + MLA_KV_LORA + MLA_ROPE), D ** -0.5),
                p + 'q_norm': gain((MLA_Q_LORA,)),
                p + 'w_uq': nrm((MLA_Q_LORA, MLA_HEADS * (MLA_NOPE + MLA_ROPE)), MLA_Q_LORA ** -0.5),
                p + 'kv_norm': gain((MLA_KV_LORA,)),
                p + 'w_ukv': nrm((MLA_KV_LORA, MLA_HEADS * (MLA_NOPE + MLA_V)), MLA_KV_LORA ** -0.5),
                p + 'w_o': nrm((MLA_HEADS * MLA_V, D), (MLA_HEADS * MLA_V) ** -0.5)}

    def dsa_params(i):
        p = 'dsa%d_' % i
        width = (DSA_HEADS * DSA_HEAD_DIM + 2 * DSA_KV_HEADS * DSA_HEAD_DIM
                 + IDX_HEADS * IDX_DIM + IDX_DIM + IDX_HEADS)
        return {p + 'w_in': nrm((D, width), D ** -0.5),
                p + 'w_o': nrm((DSA_HEADS * DSA_HEAD_DIM, D), (DSA_HEADS * DSA_HEAD_DIM) ** -0.5)}

    def rwkv_params(i):
        p = 'rwkv%d_' % i
        return {p + 'mu': jax.random.uniform(ks.pop(), (6, D), jnp.float32),
                p + 'w_r': nrm((D, D), D ** -0.5),
                p + 'w_k': nrm((D, D), D ** -0.5),
                p + 'w_v': nrm((D, D), D ** -0.5),
                p + 'w_o': nrm((D, D), D ** -0.5),
                p + 'w0': -1.0 + nrm((D,), 0.5),
                p + 'w1': nrm((D, DECAY_LORA), D ** -0.5),
                p + 'w2': nrm((DECAY_LORA, D), 0.1 * DECAY_LORA ** -0.5),
                p + 'a0': nrm((D,), 0.1),
                p + 'a1': nrm((D, AAA_LORA), D ** -0.5),
                p + 'a2': nrm((AAA_LORA, D), 0.1 * AAA_LORA ** -0.5),
                p + 'g1': nrm((D, GATE_LORA), D ** -0.5),
                p + 'g2': nrm((GATE_LORA, D), GATE_LORA ** -0.5),
                p + 'k_k': 0.85 + nrm((D,), 0.05),
                p + 'k_a': gain((D,)),
                p + 'r_k': nrm((RWKV_HEADS, RWKV_HEAD), 0.1),
                p + 'lnx_w': gain((D,)),
                p + 'lnx_b': nrm((D,), 0.01)}

    x = jax.random.normal(ks.pop(), (BATCH, SEQ, D), jnp.float32)
    start = jax.random.randint(ks.pop(), (BATCH, 1), 0, 4096, dtype=jnp.int32)
    positions = start + jnp.arange(SEQ, dtype=jnp.int32)[None, :]
    inputs = {'x': x, 'positions': positions}
    inputs.update(ffn_params(0)); inputs.update(mla_params(0))
    inputs.update(ffn_params(1)); inputs.update(dsa_params(1))
    inputs.update(ffn_params(2)); inputs.update(rwkv_params(2))
    inputs.update(ffn_params(3)); inputs.update(mla_params(3))
    inputs['final_norm'] = gain((D,))
    return inputs


def reference(x, positions,
              ffn_norm_0, ffn_w_gu_0, ffn_w_down_0, mix_norm_0,
              mla0_w_in, mla0_q_norm, mla0_w_uq, mla0_kv_norm, mla0_w_ukv, mla0_w_o,
              ffn_norm_1, ffn_w_gu_1, ffn_w_down_1, mix_norm_1,
              dsa1_w_in, dsa1_w_o,
              ffn_norm_2, ffn_w_gu_2, ffn_w_down_2, mix_norm_2,
              rwkv2_mu, rwkv2_w_r, rwkv2_w_k, rwkv2_w_v, rwkv2_w_o, rwkv2_w0, rwkv2_w1, rwkv2_w2,
              rwkv2_a0, rwkv2_a1, rwkv2_a2, rwkv2_g1, rwkv2_g2, rwkv2_k_k, rwkv2_k_a, rwkv2_r_k,
              rwkv2_lnx_w, rwkv2_lnx_b,
              ffn_norm_3, ffn_w_gu_3, ffn_w_down_3, mix_norm_3,
              mla3_w_in, mla3_q_norm, mla3_w_uq, mla3_kv_norm, mla3_w_ukv, mla3_w_o,
              final_norm):
    mixers = [
        lambda h: mla_mixer(h, positions, mla0_w_in, mla0_q_norm, mla0_w_uq,
                            mla0_kv_norm, mla0_w_ukv, mla0_w_o),
        lambda h: dsa_mixer(h, positions, dsa1_w_in, dsa1_w_o),
        lambda h: rwkv7_mixer(h, rwkv2_mu, rwkv2_w_r, rwkv2_w_k, rwkv2_w_v, rwkv2_w_o,
                              rwkv2_w0, rwkv2_w1, rwkv2_w2, rwkv2_a0, rwkv2_a1, rwkv2_a2,
                              rwkv2_g1, rwkv2_g2, rwkv2_k_k, rwkv2_k_a, rwkv2_r_k,
                              rwkv2_lnx_w, rwkv2_lnx_b),
        lambda h: mla_mixer(h, positions, mla3_w_in, mla3_q_norm, mla3_w_uq,
                            mla3_kv_norm, mla3_w_ukv, mla3_w_o),
    ]
    ffns = [(ffn_norm_0, ffn_w_gu_0, ffn_w_down_0, mix_norm_0),
            (ffn_norm_1, ffn_w_gu_1, ffn_w_down_1, mix_norm_1),
            (ffn_norm_2, ffn_w_gu_2, ffn_w_down_2, mix_norm_2),
            (ffn_norm_3, ffn_w_gu_3, ffn_w_down_3, mix_norm_3)]
    for i in range(DEPTH):
        f_norm, w_gu, w_down, m_norm = ffns[i]
        x = x + FFN_RES * swiglu(rms_norm(x, f_norm[0]), w_gu[0], w_down[0])
        x = x + mixers[i](rms_norm(x, m_norm))
        x = x + FFN_RES * swiglu(rms_norm(x, f_norm[1]), w_gu[1], w_down[1])
    return rms_norm(x, final_norm)
```

```cpp
#include <hip/hip_runtime.h>
#include <cstdio>
#include <cstdint>
__device__ __forceinline__ int opaque_tid_w(int wave_sgpr) { int t = (int)__builtin_amdgcn_mbcnt_hi(~0u, __builtin_amdgcn_mbcnt_lo(~0u, 0u)); asm volatile("" : "+v"(t)); return wave_sgpr * 64 + t; }
namespace pg8 {
#define PG8_LAS __attribute__((address_space(3)))
typedef unsigned short bf16_t;
typedef short bf16x8 __attribute__((ext_vector_type(8)));
typedef float f32x4 __attribute__((ext_vector_type(4)));
typedef unsigned u32x4 __attribute__((ext_vector_type(4)));
constexpr int BM = 256, BK = 64, HALF = 128, HTB = HALF * BK * 2  , STAGE_BYTES = 8 * HTB, NXCD = 8, WGM = 8;

__host__ __device__ __forceinline__ int lds_byte(int r, int c) { const int st = (r >> 4) * 2 + (c >> 5), rr = r & 15, cc = c & 31, ob = rr * 64 + cc * 2; return st * 1024 + (ob ^ (((ob >> 9) & 1) << 5)); }
__host__ __device__ __forceinline__ void stage_rc(int b, int& R, int& C) { const int st = b / 1024, sb = b % 1024, swz = sb ^ (((sb >> 9) & 1) << 5); R = (st >> 1) * 16 + swz / 64; C = (st & 1) * 32 + (swz % 64) / 2; }
__host__ __device__ __forceinline__ int perm32(int rho) { const int n = rho >> 4, i = rho & 15; return 8 * (i >> 2) + 4 * n + (i & 3); }

struct Unit { int pm, pn; };
struct Gemm { const bf16_t* A; const bf16_t* Bt; int M, N, K; };

struct StaticOrder {
    int nM, nN, nwg, G, c;
    __host__ __device__ void init(int M, int N, int G_, int c_) { nM = M / BM; nN = N / BM; nwg = nM * nN; G = G_; c = c_; }
    __host__ __device__ bool next(int i, Unit& u) const {
        const long L = (long)i * G + c; if (L >= nwg) return false;
        int wgid = (int)L; { const int q = nwg / NXCD, r = nwg % NXCD, xcd = wgid % NXCD, off = wgid / NXCD; wgid = (xcd < r ? xcd * (q + 1) : r * (q + 1) + (xcd - r) * q) + off; }
        const int nig = WGM * nN, gid = wgid / nig, fm = gid * WGM, gsz = (nM - fm) < WGM ? (nM - fm) : WGM;
        u.pm = fm + ((wgid % nig) % gsz); u.pn = (wgid % nig) / gsz; return true;
    }
    __device__ __forceinline__ void a_ready(const Unit&) const {}
    __device__ __forceinline__ void done(const Unit&) const {}
};
__device__ __forceinline__ unsigned cvt_pk_bf16(float lo, float hi) { unsigned r; asm volatile("v_cvt_pk_bf16_f32 %0, %1, %2" : "=v"(r) : "v"(lo), "v"(hi)); return r; }
typedef float f32x2 __attribute__((ext_vector_type(2)));
template <class Epi, class Sched, bool ALIGN_EPI = false, bool SP2 = false>
__device__ __forceinline__ void gemm_phase(PG8_LAS unsigned char* lds, const Gemm g, const Sched& S, const Epi& E, int wave_s) {
    const int tid = opaque_tid_w(wave_s), wid = wave_s, lane = tid & 63, wr = wid >> 2, wc = wid & 3, fr = lane & 15, fq = lane >> 4;
    const int K = g.K, nt = K / BK;
    unsigned voffA[2], voffB[2];
#pragma unroll
    for (int i = 0; i < 2; ++i) { int R, C; stage_rc(tid * 16 + i * 8192, R, C); const int Rb = Epi::PERM ? ((R & ~31) + perm32(R & 31)) : R;
        voffA[i] = (unsigned)(R * K + C) * 2u; voffB[i] = (unsigned)(Rb * K + C) * 2u; }
    const size_t kstep = (size_t)(BK * 2);
    const size_t hstep = (size_t)HALF * K * 2;
    const size_t tstep = 2 * hstep;
    const unsigned ldsw = (unsigned)wid * 1024u;
    const int aoff = lds_byte(wr * 64 + fr, fq * 8), boff = lds_byte(wc * 32 + fr, fq * 8);
#define PG8_SA(b, h) (((b) * 2 + (h)) * HTB)
#define PG8_SB(b, h) ((4 + (b) * 2 + (h)) * HTB)
#define PG8_STAGE(bufoff, gbase, voff) do { _Pragma("unroll") for (int _i = 0; _i < 2; ++_i) \
        __builtin_amdgcn_global_load_lds((const unsigned*)((const char*)(gbase) + (voff)[_i]), (PG8_LAS unsigned*)(lds + (bufoff) + ldsw + _i * 8192), 16, 0, 0); } while (0)
#define PG8_LDA(dst, b, h) do { _Pragma("unroll") for (int m = 0; m < 4; ++m) _Pragma("unroll") for (int k = 0; k < 2; ++k) dst[m][k] = *(const PG8_LAS bf16x8*)(lds + PG8_SA(b, h) + aoff + m * 2048 + k * 1024); } while (0)
#define PG8_LDB(dst, b, h) do { _Pragma("unroll") for (int n = 0; n < 2; ++n) _Pragma("unroll") for (int k = 0; k < 2; ++k) dst[n][k] = *(const PG8_LAS bf16x8*)(lds + PG8_SB(b, h) + boff + n * 2048 + k * 1024); } while (0)
#define PG8_MMA(ai, bj, At, Bt) do { __builtin_amdgcn_s_setprio(1); _Pragma("unroll") for (int m = 0; m < 4; ++m) _Pragma("unroll") for (int n = 0; n < 2; ++n) _Pragma("unroll") for (int k = 0; k < 2; ++k) \
        acc[ai][bj][m][n] = __builtin_amdgcn_mfma_f32_16x16x32_bf16(Bt[n][k], At[m][k], acc[ai][bj][m][n], 0, 0, 0); __builtin_amdgcn_s_setprio(0); } while (0)
#define PG8_WAIT_V(n) asm volatile("s_waitcnt vmcnt(" #n ")" ::: "memory")
#define PG8_WAIT_L(n) asm volatile("s_waitcnt lgkmcnt(" #n ")" ::: "memory")
#define PG8_BAR __builtin_amdgcn_s_barrier()
#define PG8_SCHED __builtin_amdgcn_sched_barrier(0)
    Unit cur, nxt; int ui = 0;
    if (!S.next(0, cur)) return;
    f32x4 acc[2][2][4][2];
#pragma unroll
    for (int a = 0; a < 2; ++a)
#pragma unroll
        for (int b = 0; b < 2; ++b)
#pragma unroll
            for (int m = 0; m < 4; ++m)
#pragma unroll
                for (int n = 0; n < 2; ++n) acc[a][b][m][n] = (f32x4){0.f, 0.f, 0.f, 0.f};
    bf16x8 At[4][2], B0[2][2], B1[2][2];
    const char* cA = (const char*)g.A + (size_t)cur.pm * tstep; const char* cB = (const char*)g.Bt + (size_t)cur.pn * tstep;
    S.a_ready(cur);
    if constexpr (SP2) {
        PG8_STAGE(PG8_SB(0, 0), cB, voffB); PG8_STAGE(PG8_SB(0, 1), cB + hstep, voffB); PG8_STAGE(PG8_SA(0, 0), cA, voffA); PG8_STAGE(PG8_SA(0, 1), cA + hstep, voffA);
        if (wr == 1) PG8_BAR;
        PG8_WAIT_V(2); PG8_BAR;
        PG8_STAGE(PG8_SB(1, 0), cB + kstep, voffB); PG8_STAGE(PG8_SA(1, 0), cA + kstep, voffA); PG8_STAGE(PG8_SB(1, 1), cB + hstep + kstep, voffB);
        PG8_WAIT_V(6); PG8_BAR;
    } else {
        PG8_STAGE(PG8_SB(0, 0), cB, voffB); PG8_STAGE(PG8_SA(0, 0), cA, voffA); PG8_STAGE(PG8_SB(0, 1), cB + hstep, voffB); PG8_STAGE(PG8_SA(0, 1), cA + hstep, voffA);
        if (wr == 1) PG8_BAR;
        PG8_WAIT_V(4); PG8_BAR;
        PG8_STAGE(PG8_SB(1, 0), cB + kstep, voffB); PG8_STAGE(PG8_SA(1, 0), cA + kstep, voffA); PG8_STAGE(PG8_SB(1, 1), cB + hstep + kstep, voffB);
        PG8_WAIT_V(6); PG8_BAR;
    }
    for (;;) {
        const bool has_next = S.next(ui + 1, nxt);
        const char* nA = has_next ? (const char*)g.A + (size_t)nxt.pm * tstep : cA; const char* nB = has_next ? (const char*)g.Bt + (size_t)nxt.pn * tstep : cB;
        for (int t = 0; t < nt; t += 2) {
            const bool last = (t == nt - 2);
            const char* a1 = cA + (size_t)(t + 1) * kstep;
            const char* a2 = last ? nA : cA + (size_t)(t + 2) * kstep; const char* b2 = last ? nB : cB + (size_t)(t + 2) * kstep;
            const char* a3 = a2 + kstep; const char* b3 = b2 + kstep;
            if (last && has_next) S.a_ready(nxt);
            if constexpr (SP2) {
            PG8_LDB(B0, 0, 0); PG8_LDB(B1, 0, 1); PG8_SCHED; PG8_LDA(At, 0, 0); PG8_STAGE(PG8_SA(1, 1), a1 + hstep, voffA);
            PG8_WAIT_V(8); PG8_WAIT_L(0); PG8_BAR; PG8_MMA(0, 0, At, B0); PG8_MMA(0, 1, At, B1); PG8_BAR; PG8_SCHED;
            PG8_LDA(At, 0, 1); PG8_STAGE(PG8_SB(0, 0), b2, voffB); PG8_STAGE(PG8_SB(0, 1), b2 + hstep, voffB); PG8_STAGE(PG8_SA(0, 0), a2, voffA);
            PG8_WAIT_V(8); PG8_WAIT_L(0); PG8_BAR; PG8_MMA(1, 0, At, B0); PG8_MMA(1, 1, At, B1); PG8_BAR; PG8_SCHED;
            PG8_LDB(B0, 1, 0); PG8_LDB(B1, 1, 1); PG8_SCHED; PG8_LDA(At, 1, 0); PG8_STAGE(PG8_SA(0, 1), a2 + hstep, voffA);
            PG8_WAIT_V(8); PG8_WAIT_L(0); PG8_BAR; PG8_MMA(0, 0, At, B0); PG8_MMA(0, 1, At, B1); PG8_BAR; PG8_SCHED;
            PG8_LDA(At, 1, 1); PG8_STAGE(PG8_SB(1, 0), b3, voffB); PG8_STAGE(PG8_SB(1, 1), b3 + hstep, voffB); PG8_STAGE(PG8_SA(1, 0), a3, voffA);
            PG8_WAIT_V(8); PG8_WAIT_L(0); PG8_BAR; PG8_MMA(1, 0, At, B0); PG8_MMA(1, 1, At, B1); PG8_BAR; PG8_SCHED;
            } else {
            PG8_LDB(B0, 0, 0); PG8_SCHED; PG8_LDA(At, 0, 0); PG8_STAGE(PG8_SA(1, 1), a1 + hstep, voffA);
            PG8_WAIT_L(8); PG8_BAR; PG8_WAIT_L(0); PG8_MMA(0, 0, At, B0); PG8_BAR; PG8_SCHED;
            PG8_LDB(B1, 0, 1); PG8_STAGE(PG8_SB(0, 0), b2, voffB);
            PG8_BAR; PG8_WAIT_L(0); PG8_MMA(0, 1, At, B1); PG8_BAR;
            PG8_LDA(At, 0, 1); PG8_STAGE(PG8_SA(0, 0), a2, voffA);
            PG8_BAR; PG8_WAIT_L(0); PG8_MMA(1, 0, At, B0); PG8_BAR; PG8_SCHED;
            PG8_STAGE(PG8_SB(0, 1), b2 + hstep, voffB);
            PG8_WAIT_V(6); PG8_BAR; PG8_MMA(1, 1, At, B1); PG8_BAR;
            PG8_LDB(B0, 1, 0); PG8_SCHED; PG8_LDA(At, 1, 0); PG8_STAGE(PG8_SA(0, 1), a2 + hstep, voffA);
            PG8_WAIT_L(8); PG8_BAR; PG8_WAIT_L(0); PG8_MMA(0, 0, At, B0); PG8_BAR; PG8_SCHED;
            PG8_LDB(B1, 1, 1); PG8_STAGE(PG8_SB(1, 0), b3, voffB);
            PG8_BAR; PG8_WAIT_L(0); PG8_MMA(0, 1, At, B1); PG8_BAR;
            PG8_LDA(At, 1, 1); PG8_STAGE(PG8_SA(1, 0), a3, voffA);
            PG8_BAR; PG8_WAIT_L(0); PG8_MMA(1, 0, At, B0); PG8_BAR; PG8_SCHED;
            PG8_STAGE(PG8_SB(1, 1), b3 + hstep, voffB);
            PG8_WAIT_V(6); PG8_BAR; PG8_MMA(1, 1, At, B1); PG8_BAR;
            }
        }
        if constexpr (ALIGN_EPI) { if (wr == 0) PG8_BAR; }
        if constexpr (!Epi::AFTER_DRAIN) { E(acc, cur, wr, wc, fr, fq); S.done(cur); }
        if (!has_next) break;
#pragma unroll
        for (int a = 0; a < 2; ++a)
#pragma unroll
            for (int b = 0; b < 2; ++b)
#pragma unroll
                for (int m = 0; m < 4; ++m)
#pragma unroll
                    for (int n = 0; n < 2; ++n) acc[a][b][m][n] = (f32x4){0.f, 0.f, 0.f, 0.f};
        cur = nxt; cA = nA; cB = nB; ++ui;
        if constexpr (ALIGN_EPI) { if (wr == 1) PG8_BAR; }
    }
    PG8_WAIT_V(0);
    if constexpr (!ALIGN_EPI) { if (wr == 0) PG8_BAR; }
    PG8_BAR;
    if constexpr (Epi::AFTER_DRAIN) { E.fused(acc, cur, wr, wc, fr, fq, lds, wid, lane); S.done(cur); }
#undef PG8_SA
#undef PG8_SB
#undef PG8_STAGE
#undef PG8_LDA
#undef PG8_LDB
#undef PG8_MMA
#undef PG8_WAIT_V
#undef PG8_WAIT_L
#undef PG8_BAR
#undef PG8_SCHED
}
}

#define GAS __attribute__((address_space(1)))
#define LAS __attribute__((address_space(3)))
typedef unsigned short bf16;
typedef unsigned v4u __attribute__((ext_vector_type(4)));
typedef float f32x4 __attribute__((ext_vector_type(4)));
typedef short bf16x8 __attribute__((ext_vector_type(8)));
typedef GAS unsigned gu32;
typedef GAS unsigned long long gu64;
#define RLX_AGENT __ATOMIC_RELAXED, __HIP_MEMORY_SCOPE_AGENT
#define LDS_WAIT() asm volatile("s_waitcnt lgkmcnt(0)" ::: "memory")
#define VM_WAIT() asm volatile("s_waitcnt vmcnt(0)" ::: "memory")
__device__ __forceinline__ unsigned long long rt() { return __builtin_amdgcn_s_memrealtime(); }
__device__ __forceinline__ unsigned f2bf(float f) { unsigned u = __builtin_bit_cast(unsigned, f); return (u + 0x7fffu + ((u >> 16) & 1u)) >> 16; }
__device__ __forceinline__ unsigned pk2(float lo, float hi) { return f2bf(lo) | (f2bf(hi) << 16); }

#define XB_TMO      128
#define XB_XCNT(j)  (256  + 64 * (j))
#define XB_XSUB(j)  (1280 + 64 * (j))
#define XB_XGEN(j)  (2304 + 64 * (j))
#define XB_TOP      3328
#define XB_TOPGEN   3392
#define XCD_BAR_WORDS 3456
#define XB_SPIN_CAP (1u << 18)

__device__ __forceinline__ unsigned xb_ld(unsigned* p)              { return __hip_atomic_load(p, __ATOMIC_RELAXED, __HIP_MEMORY_SCOPE_AGENT); }
__device__ __forceinline__ unsigned xb_add(unsigned* p, unsigned v) { return __hip_atomic_fetch_add(p, v, __ATOMIC_RELAXED, __HIP_MEMORY_SCOPE_AGENT); }
__device__ __forceinline__ unsigned xb_xcc_id() { return (unsigned)__builtin_amdgcn_s_getreg((3 << 11) | 20) & 0xFu; }
#define XB_SPIN(cond, bar) do { unsigned _sp = 0; while (cond) { __builtin_amdgcn_s_sleep(1); \
    if ((++_sp & 255u) == 0u) { if (xb_ld(&(bar)[XB_TMO])) break; if (_sp > XB_SPIN_CAP) { atomicAdd(&(bar)[XB_TMO], 1u); break; } } } } while (0)

struct XcdBarrier {
    unsigned* bar; unsigned x;
    volatile LAS unsigned* st;
};

__device__ __forceinline__ XcdBarrier xcd_barrier_post(unsigned* bar, volatile LAS unsigned* st) {
    XcdBarrier b; b.bar = bar; b.x = xb_xcc_id(); b.st = st;
    if (threadIdx.x == 0) (void)xb_add(&bar[XB_XCNT(b.x)], 1u);
    return b;
}
__device__ __forceinline__ void xcd_barrier_complete(unsigned* bar, unsigned x, unsigned& nloc, unsigned& nx) {
    const unsigned G = gridDim.x * gridDim.y * gridDim.z;
    unsigned sum, cnt, mine, sp = 0u;
    for (;;) {
        sum = 0u; cnt = 0u; mine = 0u;
#pragma unroll
        for (unsigned j = 0; j < 16; ++j) { const unsigned c = xb_ld(&bar[XB_XCNT(j)]); sum += c; cnt += (c > 0u) ? 1u : 0u; mine = (j == x) ? c : mine; }
        if (sum == G) break;
        __builtin_amdgcn_s_sleep(1);
        if ((++sp & 255u) == 0u) { if (xb_ld(&bar[XB_TMO])) break; if (sp > XB_SPIN_CAP) { atomicAdd(&bar[XB_TMO], 1u); break; } }
    }
    nloc = mine > 0u ? mine : 1u; nx = cnt > 0u ? cnt : 1u;
}

__device__ __forceinline__ void xcd_barrier(const XcdBarrier& b) {
    asm volatile("s_waitcnt vmcnt(0)" ::: "memory");
    __syncthreads();
    if (threadIdx.x == 0) {
        unsigned* bar = b.bar;
        __builtin_amdgcn_s_waitcnt(0);
        unsigned nloc = b.st[0], nx = b.st[1];
        if (nloc == 0u) { xcd_barrier_complete(bar, b.x, nloc, nx); b.st[0] = nloc; b.st[1] = nx; }
        const unsigned old = xb_add(&bar[XB_XSUB(b.x)], 1u);
        const unsigned gen = old / nloc;
        if (old + 1u == (gen + 1u) * nloc) {
            __builtin_amdgcn_fence(__ATOMIC_RELEASE, "agent");
            asm volatile("s_waitcnt vmcnt(0)" ::: "memory");
            const unsigned og = xb_add(&bar[XB_TOP], 1u);
            const unsigned tg = og / nx;
            if (og + 1u == (tg + 1u) * nx) xb_add(&bar[XB_TOPGEN], 1u);
            else XB_SPIN(xb_ld(&bar[XB_TOPGEN]) == tg, bar);
            __builtin_amdgcn_fence(__ATOMIC_ACQUIRE, "agent");
            xb_add(&bar[XB_XGEN(b.x)], 1u);
            asm volatile("s_waitcnt vmcnt(0)" ::: "memory");
        } else {
            XB_SPIN(xb_ld(&bar[XB_XGEN(b.x)]) == gen, bar);
            __builtin_amdgcn_fence(__ATOMIC_ACQUIRE, "agent");
            asm volatile("s_waitcnt vmcnt(0)" ::: "memory");
        }
    }
    __syncthreads();
}


constexpr int NB = 4, SEQ = 2048, MT = NB * SEQ, DM = 4096, DFF = 6144;
constexpr int NWAVES = 8, NTHR = 512;
typedef float f32x8 __attribute__((ext_vector_type(8)));
typedef float f32x16 __attribute__((ext_vector_type(16)));
typedef short s16x4 __attribute__((ext_vector_type(4)));
typedef float f32x2v __attribute__((ext_vector_type(2)));
typedef unsigned u32x2v __attribute__((ext_vector_type(2)));

constexpr size_t MiB = (size_t)1 << 20;
constexpr size_t WS_CTL = 0, CTL_BYTES = 1 * MiB;
constexpr size_t WS_T64 = WS_CTL + CTL_BYTES;
constexpr size_t WS_T128 = WS_T64 + (size_t)MT * 32 * 8;
constexpr size_t WS_WFFN = WS_T128 + (size_t)MT * 64 * 8;
constexpr size_t SZ_WGU = (size_t)2 * DFF * DM * 2, SZ_WDN = (size_t)DM * DFF * 2, SZ_FFN = SZ_WGU + SZ_WDN;
constexpr size_t SZ_SQ = (size_t)DM * DM * 2;
constexpr size_t WS_WMLA = WS_WFFN + 8 * SZ_FFN;
constexpr size_t SZ_MLA_IN = (size_t)1792 * 4096 * 2, SZ_MLA_UQ = (size_t)6144 * 1024 * 2, SZ_MLA_UKV = (size_t)8192 * 512 * 2;
constexpr size_t SZ_MLA = SZ_MLA_IN + SZ_MLA_UQ + SZ_MLA_UKV + SZ_SQ;
constexpr size_t WS_WDSA = WS_WMLA + 2 * SZ_MLA;
constexpr size_t SZ_DSA_IN = (size_t)10240 * 4096 * 2, SZ_DSA_NAR = (size_t)256 * 4096 * 2;
constexpr size_t SZ_DSA = SZ_DSA_IN + SZ_DSA_NAR + SZ_SQ;
constexpr size_t WS_WRW = WS_WDSA + SZ_DSA;
constexpr size_t RW_WR = 0, RW_WK = SZ_SQ, RW_WV = 2 * SZ_SQ, RW_WO = 3 * SZ_SQ, RW_W1 = 4 * SZ_SQ, RW_A1 = RW_W1 + 2 * MiB, RW_G1 = RW_A1 + 2 * MiB,
                 RW_W2 = RW_G1 + 4 * MiB, RW_A2 = RW_W2 + 2 * MiB, RW_G2 = RW_A2 + 2 * MiB, SZ_RW = RW_G2 + 4 * MiB;
constexpr size_t WS_HN = WS_WRW + SZ_RW;
constexpr size_t WS_OB = WS_HN + 64 * MiB;
constexpr size_t WS_SCR = WS_OB + 64 * MiB;
constexpr size_t SC_ACT = 0;
constexpr size_t ML_LAT = 0;
constexpr size_t ML_CQN = ML_LAT + 56 * MiB;
constexpr size_t ML_CKV = ML_CQN + 16 * MiB;
constexpr size_t ML_Q = ML_CKV + 8 * MiB;
constexpr size_t ML_K = ML_Q + 96 * MiB;
constexpr size_t ML_V = ML_K + 96 * MiB;
constexpr size_t ML_END = ML_V + 64 * MiB;
constexpr size_t DS_Q = 0;
constexpr size_t DS_K = DS_Q + 64 * MiB;
constexpr size_t DS_V = DS_K + 16 * MiB;
constexpr size_t DS_QI = DS_V + 16 * MiB;
constexpr size_t DS_KIW = DS_QI + 64 * MiB;
constexpr size_t DS_KI = DS_KIW + 8 * MiB;
constexpr size_t DS_WI = DS_KI + 2 * MiB;
constexpr size_t DS_SC = DS_WI + 1 * MiB;
constexpr size_t DS_MASK = DS_SC + 64 * MiB;
constexpr size_t DS_END = DS_MASK + 2 * MiB;
constexpr size_t RW_XR = 0;
constexpr size_t RW_R = 384 * MiB;
constexpr size_t RW_K = RW_R + 128 * MiB, RW_V = RW_K + 128 * MiB;
constexpr size_t RW_DEC = RW_V + 128 * MiB, RW_AA = RW_DEC + 128 * MiB, RW_G = RW_AA + 128 * MiB;
constexpr size_t RW_TW = RW_G + 128 * MiB;
constexpr size_t RW_LA = RW_TW + 4 * MiB;
constexpr size_t RW_SG = RW_LA + 4 * MiB;
constexpr size_t RW_BON = RW_SG + 8 * MiB;
constexpr size_t RW_NA = 0;
constexpr size_t RW_END = RW_BON + 2 * MiB;
constexpr size_t SCR_BYTES_WS = RW_END > ML_END ? (RW_END > DS_END ? RW_END : DS_END) : (ML_END > DS_END ? ML_END : DS_END);
constexpr size_t WS_END = WS_SCR + SCR_BYTES_WS;
static_assert(WS_END <= (size_t)3351195648ull, "workspace map exceeds sum(inputs) bytes");
static_assert((size_t)MT * DFF * 2 <= SCR_BYTES_WS, "ACT fits");
constexpr int CW_BAR = 4096;
static_assert((CW_BAR + XCD_BAR_WORDS) * 4 <= (int)CTL_BYTES, "ctl");

constexpr int RING_BYTES = 131072;
constexpr int CVT_WAVE_BYTES = 64 * 65 * 4;
constexpr int LDSCTL_OFF = 139264, LDS_BYTES = 147456;
static_assert(NWAVES * CVT_WAVE_BYTES <= LDSCTL_OFF, "lds");

__device__ __forceinline__ float wave_sum(float v) {
#pragma unroll
    for (int o = 1; o < 64; o <<= 1) v += __shfl_xor(v, o);
    return v;
}
__device__ __forceinline__ unsigned cvtpk(float lo, float hi) { unsigned r; asm volatile("v_cvt_pk_bf16_f32 %0, %1, %2" : "=v"(r) : "v"(lo), "v"(hi)); return r; }
__device__ __forceinline__ float fast_exp(float x) { return __builtin_amdgcn_exp2f(x * 1.4426950408889634f); }
__device__ __forceinline__ float fast_sigmoid(float x) { return __builtin_amdgcn_rcpf(1.0f + fast_exp(-x)); }

using pg8::f32x4; using pg8::u32x4; using pg8::Unit; using pg8::BM; using pg8::HALF;

struct EpiResid {
    static constexpr bool PERM = false, AFTER_DRAIN = false;
    float* X; int ldc; float scale;
    __device__ __forceinline__ void operator()(const f32x4 (&acc)[2][2][4][2], const Unit& u, int wr, int wc, int fr, int fq) const {
        const int row0 = u.pm * BM + wr * 64 + fr, col0 = u.pn * BM + wc * 32 + 4 * fq;
#pragma unroll
        for (int ai = 0; ai < 2; ++ai)
#pragma unroll
            for (int m = 0; m < 4; ++m) { float* rowp = X + (size_t)(row0 + ai * HALF + m * 16) * ldc + col0;
#pragma unroll
                for (int bj = 0; bj < 2; ++bj)
#pragma unroll
                    for (int n = 0; n < 2; ++n) { f32x4* p = (f32x4*)(rowp + bj * HALF + n * 16); const f32x4 old = *p; *p = old + acc[ai][bj][m][n] * scale; }
                asm volatile("" ::: "memory"); }
    }
};
struct EpiF32 {
    static constexpr bool PERM = false, AFTER_DRAIN = false;
    float* C; int ldc;
    __device__ __forceinline__ void operator()(const f32x4 (&acc)[2][2][4][2], const Unit& u, int wr, int wc, int fr, int fq) const {
        const int row0 = u.pm * BM + wr * 64 + fr, col0 = u.pn * BM + wc * 32 + 4 * fq;
#pragma unroll
        for (int ai = 0; ai < 2; ++ai)
#pragma unroll
            for (int m = 0; m < 4; ++m) { float* rowp = C + (size_t)(row0 + ai * HALF + m * 16) * ldc + col0;
#pragma unroll
                for (int bj = 0; bj < 2; ++bj)
#pragma unroll
                    for (int n = 0; n < 2; ++n) *(f32x4*)(rowp + bj * HALF + n * 16) = acc[ai][bj][m][n]; }
    }
};
__device__ __forceinline__ u32x4 pack8(const f32x4 a, const f32x4 b) { u32x4 w; w.x = cvtpk(a[0], a[1]); w.y = cvtpk(a[2], a[3]); w.z = cvtpk(b[0], b[1]); w.w = cvtpk(b[2], b[3]); return w; }
struct EpiSwiglu {
    static constexpr bool PERM = true, AFTER_DRAIN = false;
    pg8::bf16_t* O;
    __device__ __forceinline__ void operator()(const f32x4 (&acc)[2][2][4][2], const Unit& u, int wr, int wc, int fr, int fq) const {
        const int row0 = u.pm * BM + wr * 64 + fr, col0 = u.pn * HALF + wc * 32 + 8 * fq;
#pragma unroll
        for (int ai = 0; ai < 2; ++ai)
#pragma unroll
            for (int m = 0; m < 4; ++m) {
                f32x4 o[2];
#pragma unroll
                for (int n = 0; n < 2; ++n)
#pragma unroll
                    for (int j = 0; j < 4; ++j) { const float g = acc[ai][0][m][n][j], up = acc[ai][1][m][n][j]; o[n][j] = g * fast_sigmoid(g) * up; }
                *(u32x4*)(O + (size_t)(row0 + ai * HALF + m * 16) * DFF + col0) = pack8(o[0], o[1]);
            }
    }
};
__device__ __forceinline__ void rope8(f32x4& a, f32x4& b, const f32x2v* tab) {
    const f32x4 t0 = *(const f32x4*)(tab), t1 = *(const f32x4*)(tab + 2);
    f32x4 ra, rb;
    ra[0] = a[0] * t0[0] - a[1] * t0[1]; ra[1] = a[1] * t0[0] + a[0] * t0[1];
    ra[2] = a[2] * t0[2] - a[3] * t0[3]; ra[3] = a[3] * t0[2] + a[2] * t0[3];
    rb[0] = b[0] * t1[0] - b[1] * t1[1]; rb[1] = b[1] * t1[0] + b[0] * t1[1];
    rb[2] = b[2] * t1[2] - b[3] * t1[3]; rb[3] = b[3] * t1[2] + b[2] * t1[3];
    a = ra; b = rb;
}
struct EpiMlaQ {
    static constexpr bool PERM = true, AFTER_DRAIN = false;
    pg8::bf16_t* Q; const f32x2v* t64;
    __device__ __forceinline__ void operator()(const f32x4 (&acc)[2][2][4][2], const Unit& u, int wr, int wc, int fr, int fq) const {
        const int row0 = u.pm * BM + wr * 64 + fr, cA = u.pn * BM + wc * 32 + 8 * fq, hdA = cA % 192, hdB = (cA + HALF) % 192;
#pragma unroll
        for (int ai = 0; ai < 2; ++ai)
#pragma unroll
            for (int m = 0; m < 4; ++m) { const int row = row0 + ai * HALF + m * 16; pg8::bf16_t* qrow = Q + (size_t)row * 6144 + cA; const f32x2v* trow = t64 + (size_t)row * 32;
                f32x4 a = acc[ai][0][m][0], b = acc[ai][0][m][1];
                if (hdA >= 128) rope8(a, b, trow + ((hdA - 128) >> 1));
                *(u32x4*)(qrow) = pack8(a, b);
                f32x4 c = acc[ai][1][m][0], d = acc[ai][1][m][1];
                if (hdB >= 128) rope8(c, d, trow + ((hdB - 128) >> 1));
                *(u32x4*)(qrow + HALF) = pack8(c, d);
                asm volatile("" ::: "memory"); }
    }
};
struct EpiMlaKV {
    static constexpr bool PERM = true, AFTER_DRAIN = false;
    pg8::bf16_t* KF; pg8::bf16_t* VB;
    __device__ __forceinline__ void operator()(const f32x4 (&acc)[2][2][4][2], const Unit& u, int wr, int wc, int fr, int fq) const {
        const int row0 = u.pm * BM + wr * 64 + fr, h = u.pn, cc = wc * 32 + 8 * fq;
#pragma unroll
        for (int ai = 0; ai < 2; ++ai)
#pragma unroll
            for (int m = 0; m < 4; ++m) { const size_t row = (size_t)(row0 + ai * HALF + m * 16);
                *(u32x4*)(KF + row * 6144 + h * 192 + cc) = pack8(acc[ai][0][m][0], acc[ai][0][m][1]);
                *(u32x4*)(VB + row * 4096 + h * 128 + cc) = pack8(acc[ai][1][m][0], acc[ai][1][m][1]); asm volatile("" ::: "memory"); }
    }
};
struct EpiDsaIn {
    static constexpr bool PERM = true, AFTER_DRAIN = false;
    pg8::bf16_t *QD, *KD, *VD, *QI; const f32x2v *t64, *t128;
    __device__ __forceinline__ void operator()(const f32x4 (&acc)[2][2][4][2], const Unit& u, int wr, int wc, int fr, int fq) const {
        const int row0 = u.pm * BM + wr * 64 + fr, pn = u.pn;
        pg8::bf16_t* base; int ld, cbase, mode;
        if (pn < 16) { base = QD; ld = 4096; cbase = pn * BM; mode = 1; }
        else if (pn < 20) { base = KD; ld = 1024; cbase = (pn - 16) * BM; mode = 1; }
        else if (pn < 24) { base = VD; ld = 1024; cbase = (pn - 20) * BM; mode = 0; }
        else { base = QI; ld = 4096; cbase = (pn - 24) * BM; mode = 2; }
        const int c0 = cbase + wc * 32 + 8 * fq, d0 = c0 & 127;
        const bool r64 = mode == 2 && d0 < 64;
#pragma unroll
        for (int ai = 0; ai < 2; ++ai)
#pragma unroll
            for (int m = 0; m < 4; ++m) { const int row = row0 + ai * HALF + m * 16; pg8::bf16_t* orow = base + (size_t)row * ld + c0;
                f32x4 a = acc[ai][0][m][0], b = acc[ai][0][m][1], c = acc[ai][1][m][0], d = acc[ai][1][m][1];
                if (mode == 1) { const f32x2v* tr = t128 + (size_t)row * 64 + (d0 >> 1); rope8(a, b, tr); rope8(c, d, tr); }
                else if (r64) { const f32x2v* tr = t64 + (size_t)row * 32 + (d0 >> 1); rope8(a, b, tr); rope8(c, d, tr); }
                *(u32x4*)(orow) = pack8(a, b); *(u32x4*)(orow + HALF) = pack8(c, d);
                asm volatile("" ::: "memory"); }
    }
};
struct EpiActBf16 {
    static constexpr bool PERM = true, AFTER_DRAIN = false;
    pg8::bf16_t* O; int ldc; int act;
    __device__ __forceinline__ void operator()(const f32x4 (&acc)[2][2][4][2], const Unit& u, int wr, int wc, int fr, int fq) const {
        const int row0 = u.pm * BM + wr * 64 + fr;
#pragma unroll
        for (int bj = 0; bj < 2; ++bj) {
            const int c0 = u.pn * BM + bj * HALF + wc * 32 + 8 * fq;
#pragma unroll
            for (int ai = 0; ai < 2; ++ai)
#pragma unroll
                for (int m = 0; m < 4; ++m) { f32x4 v[2] = {acc[ai][bj][m][0], acc[ai][bj][m][1]};
                    if (act == 1) {
#pragma unroll
                        for (int n = 0; n < 2; ++n)
#pragma unroll
                            for (int j = 0; j < 4; ++j) { const float x = v[n][j], e = fast_exp(-2.0f * fabsf(x)), t = (1.0f - e) * __builtin_amdgcn_rcpf(1.0f + e); v[n][j] = x < 0.f ? -t : t; }
                    } else if (act == 2) {
#pragma unroll
                        for (int n = 0; n < 2; ++n)
#pragma unroll
                            for (int j = 0; j < 4; ++j) v[n][j] = fast_sigmoid(v[n][j]);
                    }
                    *(u32x4*)(O + (size_t)(row0 + ai * HALF + m * 16) * ldc + c0) = pack8(v[0], v[1]); }
        }
    }
};
struct EpiRw2 {
    static constexpr bool PERM = false, AFTER_DRAIN = false;
    float* C; const float* vec; int mode;
    __device__ __forceinline__ void operator()(const f32x4 (&acc)[2][2][4][2], const Unit& u, int wr, int wc, int fr, int fq) const {
        const int row0 = u.pm * BM + wr * 64 + fr, col0 = u.pn * BM + wc * 32 + 4 * fq;
#pragma unroll
        for (int bj = 0; bj < 2; ++bj)
#pragma unroll
            for (int n = 0; n < 2; ++n) { const int c = col0 + bj * HALF + n * 16;
                f32x4 bv = (f32x4){0.f, 0.f, 0.f, 0.f}; if (mode != 2) bv = *(const f32x4*)(vec + c);
#pragma unroll
                for (int ai = 0; ai < 2; ++ai)
#pragma unroll
                    for (int m = 0; m < 4; ++m) { f32x4 v = acc[ai][bj][m][n] + bv;
                        if (mode == 0) {
#pragma unroll
                            for (int j = 0; j < 4; ++j) { const float z = -v[j];
                                const float sp = fmaxf(z, 0.f) + __logf(1.0f + fast_exp(-fabsf(z)));
                                v[j] = fast_exp(-fast_exp(-sp - 0.5f)); }
                        } else if (mode == 1) {
#pragma unroll
                            for (int j = 0; j < 4; ++j) v[j] = fast_sigmoid(v[j]);
                        }
                        *(f32x4*)(C + (size_t)(row0 + ai * HALF + m * 16) * DM + c) = v; }
            }
    }
};

struct DstNat { bf16* base; int ld; int N;
    __device__ __forceinline__ bf16* operator()(int n) const { return n < N ? base + (size_t)n * ld : nullptr; } };
struct DstGU { bf16* base;
    __device__ __forceinline__ bf16* operator()(int n) const { const int up = n >= DFF, j = up ? n - DFF : n; return base + (size_t)(256 * (j >> 7) + 128 * up + (j & 127)) * DM; } };
struct DstUQ { bf16* base;
    __device__ __forceinline__ bf16* operator()(int n) const { const int h = n / 192; int d = n - h * 192;
        if (d >= 128) { const int i = d - 128; d = 128 + (i < 32 ? 2 * i : 2 * (i - 32) + 1); }
        return base + (size_t)(h * 192 + d) * 1024; } };
struct DstDsaIn { bf16* main; bf16* nar;
    __device__ __forceinline__ bf16* operator()(int n) const {
        if (n >= 10400) return nullptr;
        if (n < 5120) { const int d = n & 127, dd = d < 64 ? 2 * d : 2 * (d - 64) + 1; return main + (size_t)((n & ~127) + dd) * DM; }
        if (n < 6144) return main + (size_t)n * DM;
        if (n < 10368) { const int d = n & 127, dd = d < 32 ? 2 * d : (d < 64 ? 2 * (d - 32) + 1 : d);
            return n < 10240 ? main + (size_t)((n & ~127) + dd) * DM : nar + (size_t)dd * DM; }
        return nar + (size_t)(128 + n - 10368) * DM; } };

template <class Dst>
__device__ __forceinline__ void cvt_tile(const float* __restrict__ W, int Ksrc, int N, int k0, int n0, LAS float* scr, int lane, const Dst& dst) {
    const int kr = lane >> 4, nc = (lane & 15) * 4;
    f32x4 v[16];
#pragma unroll
    for (int i = 0; i < 16; ++i) { const int k = k0 + 4 * i + kr, n = n0 + nc;
        v[i] = (f32x4){0.f, 0.f, 0.f, 0.f};
        if (k < Ksrc && n < N) v[i] = __builtin_nontemporal_load((const f32x4*)(W + (size_t)k * N + n)); }
#pragma unroll
    for (int i = 0; i < 16; ++i) { LAS float* s = scr + (4 * i + kr) * 65 + nc; s[0] = v[i][0]; s[1] = v[i][1]; s[2] = v[i][2]; s[3] = v[i][3]; }
    LDS_WAIT(); asm volatile("" ::: "memory");
    const int c = lane & 7;
#pragma unroll
    for (int j = 0; j < 8; ++j) { const int nl = (lane >> 3) + 8 * j; const LAS float* s = scr + (8 * c) * 65 + nl;
        v4u o; o.x = cvtpk(s[0], s[65]); o.y = cvtpk(s[2 * 65], s[3 * 65]); o.z = cvtpk(s[4 * 65], s[5 * 65]); o.w = cvtpk(s[6 * 65], s[7 * 65]);
        bf16* d = dst(n0 + nl);
        if (d) *(v4u*)(d + k0 + 8 * c) = o; }
    LDS_WAIT(); asm volatile("" ::: "memory");
}
struct CvtCursor { int gw, ngw, rot; };
template <class Dst>
__device__ __forceinline__ void cvt_matrix(const float* W, int Ksrc, int Kdst, int N, const Dst& dst, CvtCursor& cur, LAS float* scr, int lane) {
    const int nnb = (N + 63) / 64, cnt = (Kdst / 64) * nnb;
    int first = cur.gw - cur.rot; if (first < 0) first += cur.ngw;
    for (int it = first; it < cnt; it += cur.ngw) { const int kb = it / nnb, nb = it - kb * nnb; cvt_tile(W, Ksrc, N, kb * 64, nb * 64, scr, lane, dst); }
    cur.rot = (cur.rot + cnt) % cur.ngw;
}
__device__ __forceinline__ void zero_bytes(void* p, size_t bytes, int gtid, int gthreads) {
    v4u* q = (v4u*)p; const size_t n = bytes / 16;
    for (size_t i = gtid; i < n; i += gthreads) q[i] = (v4u){0u, 0u, 0u, 0u};
}
__device__ __forceinline__ void sincos_acc(float ang, float& c, float& s) {
    double r = (double)ang; r -= 6.283185307179586476925 * __builtin_rint(r * 0.15915494309189533577);
    const double r2 = r * r;
    double sn = 1.0, cs = 1.0;
#pragma unroll
    for (int k = 12; k >= 1; --k) { sn = 1.0 - sn * r2 / (double)((2 * k) * (2 * k + 1)); cs = 1.0 - cs * r2 / (double)((2 * k - 1) * (2 * k)); }
    s = (float)(sn * r); c = (float)cs;
}
__device__ __forceinline__ void rope_tables(const int* pos, f32x2v* t64, f32x2v* t128, int gtid, int gthreads) {
    for (int idx = gtid; idx < MT * 96; idx += gthreads) { const int tok = idx / 96, i = idx - tok * 96;
        const bool big = i >= 32; const int ii = big ? i - 32 : i;
        const double e = big ? (double)(2 * ii) / 128.0 : (double)(2 * ii) / 64.0;
        const float inv = (float)exp2(-e * 13.287712379549449);
        const float ang = (float)pos[tok] * inv;
        float c, s; sincos_acc(ang, c, s);
        (big ? t128 + (size_t)tok * 64 : t64 + (size_t)tok * 32)[ii] = (f32x2v){c, s}; }
}

__device__ __forceinline__ unsigned long long pk4(float a, float b, float c, float d) { return (unsigned long long)cvtpk(a, b) | ((unsigned long long)cvtpk(c, d) << 32); }
__device__ __forceinline__ void rmsnorm_row(const float* xrow, const float* gain, bf16* orow, float* xcopy, int lane) {
    const f32x4* xr = (const f32x4*)xrow + lane; f32x4 v[16]; float s = 0.f;
#pragma unroll
    for (int j = 0; j < 16; ++j) { v[j] = xr[64 * j]; s += (v[j][0] * v[j][0] + v[j][1] * v[j][1]) + (v[j][2] * v[j][2] + v[j][3] * v[j][3]); }
    const float rstd = 1.0f / sqrtf(wave_sum(s) * (1.0f / DM) + 1e-6f);
    if (xcopy) {
#pragma unroll
        for (int j = 0; j < 16; ++j) ((f32x4*)xcopy + lane)[64 * j] = v[j]; }
    unsigned long long* o8 = (unsigned long long*)orow + lane;
#pragma unroll
    for (int j = 0; j < 16; ++j) { const f32x4 g = ((const f32x4*)gain + lane)[64 * j];
        o8[64 * j] = pk4(v[j][0] * rstd * g[0], v[j][1] * rstd * g[1], v[j][2] * rstd * g[2], v[j][3] * rstd * g[3]); }
}
__device__ __forceinline__ void phase_rmsnorm(const float* X, const float* gain, bf16* HN, float* xcopy, int gw, int ngw, int lane) {
    for (int m = gw; m < MT; m += ngw) rmsnorm_row(X + (size_t)m * DM, gain, HN + (size_t)m * DM, xcopy ? xcopy + (size_t)m * DM : nullptr, lane);
}
__device__ __forceinline__ void phase_final_norm(float* X, const float* gain, int gw, int ngw, int lane) {
    for (int m = gw; m < MT; m += ngw) { f32x4* xr = (f32x4*)(X + (size_t)m * DM) + lane; f32x4 v[16]; float s = 0.f;
#pragma unroll
        for (int j = 0; j < 16; ++j) { v[j] = xr[64 * j]; s += (v[j][0] * v[j][0] + v[j][1] * v[j][1]) + (v[j][2] * v[j][2] + v[j][3] * v[j][3]); }
        const float rstd = 1.0f / sqrtf(wave_sum(s) * (1.0f / DM) + 1e-6f);
#pragma unroll
        for (int j = 0; j < 16; ++j) { const f32x4 g = ((const f32x4*)gain + lane)[64 * j]; xr[64 * j] = v[j] * rstd * g; } }
}
__device__ __forceinline__ void phase_mla_latnorm(const float* LAT, const float* qn, const float* kvn, const f32x2v* t64, bf16* CQN, bf16* CKV, bf16* KF, int gw, int ngw, int lane) {
    for (int m = gw; m < MT; m += ngw) { const float* lr = LAT + (size_t)m * 1792;
        f32x4 a[4], b[2]; float sa = 0.f, sb = 0.f;
#pragma unroll
        for (int j = 0; j < 4; ++j) { a[j] = ((const f32x4*)lr + lane)[64 * j]; sa += (a[j][0] * a[j][0] + a[j][1] * a[j][1]) + (a[j][2] * a[j][2] + a[j][3] * a[j][3]); }
#pragma unroll
        for (int j = 0; j < 2; ++j) { b[j] = ((const f32x4*)(lr + 1024) + lane)[64 * j]; sb += (b[j][0] * b[j][0] + b[j][1] * b[j][1]) + (b[j][2] * b[j][2] + b[j][3] * b[j][3]); }
        const float ra = 1.0f / sqrtf(wave_sum(sa) * (1.0f / 1024.0f) + 1e-6f), rb = 1.0f / sqrtf(wave_sum(sb) * (1.0f / 512.0f) + 1e-6f);
#pragma unroll
        for (int j = 0; j < 4; ++j) { const f32x4 g = ((const f32x4*)qn + lane)[64 * j];
            ((unsigned long long*)(CQN + (size_t)m * 1024) + lane)[64 * j] = pk4(a[j][0] * ra * g[0], a[j][1] * ra * g[1], a[j][2] * ra * g[2], a[j][3] * ra * g[3]); }
#pragma unroll
        for (int j = 0; j < 2; ++j) { const f32x4 g = ((const f32x4*)kvn + lane)[64 * j];
            ((unsigned long long*)(CKV + (size_t)m * 512) + lane)[64 * j] = pk4(b[j][0] * rb * g[0], b[j][1] * rb * g[1], b[j][2] * rb * g[2], b[j][3] * rb * g[3]); }
        const int i = lane & 31; const float x1 = lr[1536 + i], x2 = lr[1568 + i]; const f32x2v cs = t64[(size_t)m * 32 + i];
        const unsigned w = cvtpk(x1 * cs[0] - x2 * cs[1], x2 * cs[0] + x1 * cs[1]);
        unsigned* kr = (unsigned*)(KF + (size_t)m * 6144 + 128) + i;
#pragma unroll
        for (int hh = 0; hh < 16; ++hh) kr[(2 * hh + (lane >> 5)) * 96] = w;
    }
}
__device__ __forceinline__ void phase_dsa_kiw(const float* KIW, const f32x2v* t64, bf16* KI, float* WI, int gw, int ngw, int lane) {
    for (int m = gw; m < MT; m += ngw) { const float* r = KIW + (size_t)m * 256;
        const f32x2v x = *(const f32x2v*)(r + 2 * lane);
        float o0 = x[0], o1 = x[1];
        if (lane < 32) { const f32x2v cs = t64[(size_t)m * 32 + lane]; o0 = x[0] * cs[0] - x[1] * cs[1]; o1 = x[1] * cs[0] + x[0] * cs[1]; }
        ((unsigned*)(KI + (size_t)m * 128))[lane] = cvtpk(o0, o1);
        if (lane < 32) WI[(size_t)m * 32 + lane] = r[128 + lane] * 0.015625f;
    }
}
__device__ __forceinline__ void rw_norm_regs(const float* xrow, const float* gain, f32x4 (&h)[16], int lane) {
    const f32x4* xr = (const f32x4*)xrow + lane; float s = 0.f;
#pragma unroll
    for (int j = 0; j < 16; ++j) { h[j] = xr[64 * j]; s += (h[j][0] * h[j][0] + h[j][1] * h[j][1]) + (h[j][2] * h[j][2] + h[j][3] * h[j][3]); }
    const float rstd = 1.0f / sqrtf(wave_sum(s) * (1.0f / DM) + 1e-6f);
#pragma unroll
    for (int j = 0; j < 16; ++j) { const f32x4 g = ((const f32x4*)gain + lane)[64 * j]; h[j] = h[j] * rstd * g; }
}
__device__ __forceinline__ void phase_rwkv_mix(const float* X, const float* gain, const float* mu, bf16* XM, int gw, int ngw, int lane) {
    constexpr int RPW = 4;
    for (int it = gw; it < MT / RPW; it += ngw) { const int m0 = it * RPW;
        f32x4 hp[16], hc[16];
        if ((m0 & (SEQ - 1)) == 0) {
#pragma unroll
            for (int j = 0; j < 16; ++j) hp[j] = (f32x4){0.f, 0.f, 0.f, 0.f};
        } else rw_norm_regs(X + (size_t)(m0 - 1) * DM, gain, hp, lane);
        for (int rr = 0; rr < RPW; ++rr) { const int m = m0 + rr;
            rw_norm_regs(X + (size_t)m * DM, gain, hc, lane);
#pragma unroll 1
            for (int s = 0; s < 6; ++s) { unsigned long long* o8 = (unsigned long long*)(XM + (size_t)s * MT * DM + (size_t)m * DM) + lane;
#pragma unroll
                for (int j = 0; j < 16; ++j) { const f32x4 mv = ((const f32x4*)(mu + s * DM) + lane)[64 * j]; const f32x4 y = hc[j] + (hp[j] - hc[j]) * mv;
                    o8[64 * j] = pk4(y[0], y[1], y[2], y[3]); } }
#pragma unroll
            for (int j = 0; j < 16; ++j) hp[j] = hc[j];
        }
    }
}
__device__ __forceinline__ void phase_rwkv_prep(float* K, float* AA, const float* R, float* NA, float* BON, const float* k_k, const float* k_a, const float* r_k, int gw, int ngw, int lane) {
    for (int m = gw; m < MT; m += ngw) {
#pragma unroll 4
        for (int h = 0; h < 64; ++h) { const int c = h * 64 + lane; const size_t idx = (size_t)m * DM + c;
            const float kv = K[idx], av = AA[idx], rv = R[idx];
            const float kr = kv * k_k[c]; const float ss = wave_sum(kr * kr); const float kk = kr / fmaxf(sqrtf(ss), 1e-12f);
            const float kp = kv * (1.0f + (av - 1.0f) * k_a[c]);
            const float bon = wave_sum(rv * kp * r_k[c]);
            K[idx] = kp; AA[idx] = kk * av; NA[idx] = -kk; if (lane == 0) BON[(size_t)m * 64 + h] = bon; }
    }
}

namespace att {
#define ATT_SBAR() __builtin_amdgcn_sched_barrier(0)
__device__ __forceinline__ int crow(int r, int hi) { return (r & 3) + 8 * (r >> 2) + 4 * hi; }
__device__ __forceinline__ int v_st(int k, int c) { const int kk = (k & ~0xC) | ((k & 4) << 1) | ((k & 8) >> 1); return ((kk >> 3) * 4 + (c >> 5)) * 512 + ((kk & 7) * 32 + (c & 31)) * 2; }
__device__ __forceinline__ int v_rd_base(int lane) { return ((lane & 3) << 3) | (((lane >> 2) & 3) << 6) | (((lane >> 4) & 1) << 5) | (((lane >> 5) & 1) << 8); }
constexpr int v_rd_off(int d0, int ks, int half) { return d0 * 512 + ks * 4096 + half * 2048; }
template <int OFF> __device__ __forceinline__ s16x4 tr_read(int vb) { s16x4 r; asm volatile("ds_read_b64_tr_b16 %0, %1 offset:%2" : "=&v"(r) : "v"(vb), "i"(OFF) : "memory"); return r; }
template <int D0> __device__ __forceinline__ void pv_one(f32x16& od, int vb, bf16x8 pa0, bf16x8 pa1, bf16x8 pa2, bf16x8 pa3) {
    const s16x4 l0 = tr_read<v_rd_off(D0, 0, 0)>(vb), h0 = tr_read<v_rd_off(D0, 0, 1)>(vb), l1 = tr_read<v_rd_off(D0, 1, 0)>(vb), h1 = tr_read<v_rd_off(D0, 1, 1)>(vb);
    const s16x4 l2 = tr_read<v_rd_off(D0, 2, 0)>(vb), h2 = tr_read<v_rd_off(D0, 2, 1)>(vb), l3 = tr_read<v_rd_off(D0, 3, 0)>(vb), h3 = tr_read<v_rd_off(D0, 3, 1)>(vb);
    asm volatile("s_waitcnt lgkmcnt(0)" ::: "memory"); ATT_SBAR();
#define ATT_PK(L, H) (bf16x8){L[0], L[1], L[2], L[3], H[0], H[1], H[2], H[3]}
    od = __builtin_amdgcn_mfma_f32_32x32x16_bf16(pa0, ATT_PK(l0, h0), od, 0, 0, 0);
    od = __builtin_amdgcn_mfma_f32_32x32x16_bf16(pa1, ATT_PK(l1, h1), od, 0, 0, 0);
    od = __builtin_amdgcn_mfma_f32_32x32x16_bf16(pa2, ATT_PK(l2, h2), od, 0, 0, 0);
    od = __builtin_amdgcn_mfma_f32_32x32x16_bf16(pa3, ATT_PK(l3, h3), od, 0, 0, 0);
#undef ATT_PK
}
__device__ __forceinline__ void pv_d0(f32x16* o, int vb, bf16x8 pa0, bf16x8 pa1, bf16x8 pa2, bf16x8 pa3) {
    pv_one<0>(o[0], vb, pa0, pa1, pa2, pa3); pv_one<1>(o[1], vb, pa0, pa1, pa2, pa3); pv_one<2>(o[2], vb, pa0, pa1, pa2, pa3); pv_one<3>(o[3], vb, pa0, pa1, pa2, pa3);
}
template <bool MASKED>
__device__ __forceinline__ void partialSM(f32x16& p0, f32x16& p1, float& m_reg, float& mn, float& alpha, float C, float THRS, bool tile_valid, u32x2v mk, int hi) {
    const float NINF = -__builtin_inff();
    if (MASKED) { const unsigned b0 = tile_valid ? (mk[0] >> (4 * hi)) : 0u, b1 = tile_valid ? (mk[1] >> (4 * hi)) : 0u;
#pragma unroll
        for (int r = 0; r < 16; ++r) { const int sh = (r & 3) + 8 * (r >> 2); p0[r] = ((b0 >> sh) & 1u) ? p0[r] : NINF; p1[r] = ((b1 >> sh) & 1u) ? p1[r] : NINF; }
    } else if (!tile_valid) {
#pragma unroll
        for (int r = 0; r < 16; ++r) { p0[r] = NINF; p1[r] = NINF; }
    }
    float pmax = p0[0];
#pragma unroll
    for (int r = 1; r < 16; ++r) pmax = fmaxf(pmax, p0[r]);
#pragma unroll
    for (int r = 0; r < 16; ++r) pmax = fmaxf(pmax, p1[r]);
    { auto rr = __builtin_amdgcn_permlane32_swap(__float_as_uint(pmax), __float_as_uint(pmax), false, false); pmax = fmaxf(__uint_as_float(rr[0]), __uint_as_float(rr[1])); }
    if (__builtin_expect(__all(pmax - m_reg <= THRS), 1)) { mn = m_reg; alpha = 1.f; }
    else { mn = fmaxf(m_reg, pmax); alpha = __builtin_amdgcn_exp2f((m_reg - mn) * C); m_reg = mn; }
    const float mnC = -mn * C;
#pragma unroll
    for (int r = 0; r < 16; ++r) p0[r] = fmaf(p0[r], C, mnC);
#pragma unroll
    for (int r = 0; r < 16; ++r) p1[r] = fmaf(p1[r], C, mnC);
#pragma unroll
    for (int r = 0; r < 16; ++r) p0[r] = __builtin_amdgcn_exp2f(p0[r]);
}
__device__ __forceinline__ void finishSM(f32x16& p0, f32x16& p1, float alpha, float& l_reg, bf16x8& pa0, bf16x8& pa1, bf16x8& pa2, bf16x8& pa3) {
#pragma unroll
    for (int r = 0; r < 16; ++r) p1[r] = __builtin_amdgcn_exp2f(p1[r]);
    float ps = 0;
#pragma unroll
    for (int r = 0; r < 16; ++r) ps += p0[r];
#pragma unroll
    for (int r = 0; r < 16; ++r) ps += p1[r];
    { auto rr = __builtin_amdgcn_permlane32_swap(__float_as_uint(ps), __float_as_uint(ps), false, false); ps = __uint_as_float(rr[0]) + __uint_as_float(rr[1]); }
    l_reg = l_reg * alpha + ps;
#define ATT_PK4(P, BASE, OUT) do { unsigned a0 = cvtpk(P[BASE + 0], P[BASE + 1]), a1 = cvtpk(P[BASE + 2], P[BASE + 3]);   \
    unsigned b0 = cvtpk(P[BASE + 4], P[BASE + 5]), b1 = cvtpk(P[BASE + 6], P[BASE + 7]);                              \
    auto r0 = __builtin_amdgcn_permlane32_swap(a0, b0, false, false); auto r1 = __builtin_amdgcn_permlane32_swap(a1, b1, false, false); \
    u32x4 w = {r0[0], r1[0], r0[1], r1[1]}; OUT = *reinterpret_cast<bf16x8*>(&w); } while (0)
    ATT_PK4(p0, 0, pa0); ATT_PK4(p0, 8, pa1); ATT_PK4(p1, 0, pa2); ATT_PK4(p1, 8, pa3);
#undef ATT_PK4
}
template <int DQK, int LDQ, int LDK, int LDV, bool MASKED>
__device__ __forceinline__ void attn_unit(const bf16* __restrict__ Qb, const bf16* __restrict__ Kh, const bf16* __restrict__ Vh, bf16* __restrict__ Ob,
                                          const unsigned* __restrict__ mask0, int qb, float C, float THRS, char* lds, int wave_s) {
    constexpr int KROW = DQK * 2, SHM_K = 64 * KROW, SHM_V = 64 * 128 * 2, NQF = DQK / 16, KCH = DQK / 8, KST = DQK / 64;
#define ATT_KSWZ(row, colB) ((row) * KROW + ((colB) ^ (((row) & 7) << 4)))
    const int tid = opaque_tid_w(wave_s), wid = wave_s, lane = tid & 63, r32 = lane & 31, hi = lane >> 5;
    char* V_lds = lds; char* K_lds = lds + 2 * SHM_V;
    float* wsf = (float*)(lds + 2 * SHM_V + 2 * SHM_K) + wid * 64; float* li_l = wsf; float* al_l = wsf + 32;
    const int NT = 4 * (qb + 1), lim = 4 * qb + (wid >> 1) + 1;
    float m_reg = -1e30f, l_reg = 0; f32x16 o[4] = {}; bf16x8 qr[NQF];
    const bf16* Qw = Qb + (size_t)(wid * 32 + r32) * LDQ + hi * 8;
#pragma unroll
    for (int d0 = 0; d0 < NQF; ++d0) qr[d0] = *(const bf16x8*)(Qw + d0 * 16);
    const unsigned* mrow = MASKED ? mask0 + (size_t)(wid * 32 + r32) * 64 : nullptr;
    int voff[2], koff[KST];
#pragma unroll
    for (int i = 0; i < 2; ++i) { const int L = (tid + 512 * i) * 16, st = L >> 9, w = (L & 511) >> 1, kk = ((st >> 2) << 3) | (w >> 5), c = ((st & 3) << 5) | (w & 31);
        const int k = (kk & ~0xC) | ((kk & 4) << 1) | ((kk & 8) >> 1); voff[i] = k * LDV + c; }
#pragma unroll
    for (int i = 0; i < KST; ++i) { const int L = (tid + 512 * i) * 16, row = L / KROW, cb = (L - row * KROW) ^ ((row & 7) << 4); koff[i] = row * LDK + (cb >> 1); }
    const int vb0 = (int)(uintptr_t)V_lds + v_rd_base(lane);
    typedef __attribute__((address_space(3))) unsigned lds_u32;
#define ATT_STAGE(k0, b) do { \
    _Pragma("unroll") for (int _i = 0; _i < 2; ++_i) __builtin_amdgcn_global_load_lds((const unsigned*)(Vh + (size_t)(k0) * LDV + voff[_i]), (lds_u32*)(V_lds + (b) * SHM_V + wid * 1024 + _i * 8192), 16, 0, 0); \
    _Pragma("unroll") for (int _i = 0; _i < KST; ++_i) __builtin_amdgcn_global_load_lds((const unsigned*)(Kh + (size_t)(k0) * LDK + koff[_i]), (lds_u32*)(K_lds + (b) * SHM_K + wid * 1024 + _i * 8192), 16, 0, 0); } while (0)
#define ATT_QKT(P0, P1, b) do { P0 = f32x16{}; P1 = f32x16{}; const char* _Ks = K_lds + (b) * SHM_K; \
    _Pragma("unroll") for (int d0 = 0; d0 < NQF; ++d0) { const int cb = (d0 * 16 + hi * 8) * 2; \
        const bf16x8 b0 = *(const bf16x8*)(_Ks + ATT_KSWZ(r32, cb)); const bf16x8 b1 = *(const bf16x8*)(_Ks + ATT_KSWZ(32 + r32, cb)); \
        P0 = __builtin_amdgcn_mfma_f32_32x32x16_bf16(b0, qr[d0], P0, 0, 0, 0); P1 = __builtin_amdgcn_mfma_f32_32x32x16_bf16(b1, qr[d0], P1, 0, 0, 0); } } while (0)
#define ATT_RESC(a) do { if (__any((a) < 1.f)) { if (hi == 0) al_l[r32] = (a); asm volatile("s_waitcnt lgkmcnt(0)" ::: "memory"); \
    _Pragma("unroll") for (int d = 0; d < 4; ++d) _Pragma("unroll") for (int r = 0; r < 16; ++r) o[d][r] *= al_l[crow(r, hi)]; } } while (0)
#define ATT_MASKW(j) (MASKED ? *(const u32x2v*)(mrow + 2 * (j)) : (u32x2v){0u, 0u})
    f32x16 p0, p1; float mn, al; bf16x8 pa0, pa1, pa2, pa3; u32x2v mk;
    ATT_STAGE(0, 0); asm volatile("s_waitcnt vmcnt(0)" ::: "memory"); __syncthreads();
    for (int j = 0; j < NT; ++j) {
        const int buf = j & 1;
        mk = ATT_MASKW(j);
        if (j + 1 < NT) ATT_STAGE((j + 1) * 64, buf ^ 1);
        ATT_SBAR();
        ATT_QKT(p0, p1, buf);
        partialSM<MASKED>(p0, p1, m_reg, mn, al, C, THRS, j < lim, mk, hi);
        ATT_RESC(al);
        finishSM(p0, p1, al, l_reg, pa0, pa1, pa2, pa3); ATT_SBAR();
        pv_d0(o, vb0 + buf * SHM_V, pa0, pa1, pa2, pa3);
        asm volatile("s_waitcnt vmcnt(0)" ::: "memory");
        __syncthreads();
    }
    if (hi == 0) li_l[r32] = l_reg; asm volatile("s_waitcnt lgkmcnt(0)" ::: "memory");
    float rli[16];
#pragma unroll
    for (int r = 0; r < 16; ++r) rli[r] = __builtin_amdgcn_rcpf(li_l[crow(r, hi)]);
    __syncthreads();
    unsigned short* stg = (unsigned short*)(lds + wid * 8192);
#pragma unroll
    for (int r = 0; r < 16; ++r) { const int orow = crow(r, hi);
#pragma unroll
        for (int d0 = 0; d0 < 4; ++d0) stg[orow * 128 + d0 * 32 + r32] = (unsigned short)(cvtpk(o[d0][r] * rli[r], 0.f) & 0xffffu); }
    asm volatile("s_waitcnt lgkmcnt(0)" ::: "memory");
    bf16* Ow = Ob + (size_t)(wid * 32) * 4096;
#pragma unroll
    for (int i = 0; i < 8; ++i) { const int idx = lane + 64 * i, row = idx >> 4, ch = idx & 15;
        const u32x4 w = *(const u32x4*)((const char*)stg + row * 256 + ch * 16);
        *(u32x4*)(Ow + (size_t)row * 4096 + ch * 8) = w; }
    __syncthreads();
#undef ATT_STAGE
#undef ATT_QKT
#undef ATT_RESC
#undef ATT_MASKW
#undef ATT_KSWZ
}
__device__ __forceinline__ void unit_of(int it, int& bh, int& qb) { const int j = it & 255, s = it >> 8; bh = j >> 1; const int base = 2 * (j & 1) + (s >> 1); qb = (s & 1) ? 7 - base : base; }
}

__device__ __forceinline__ void phase_dsa_indexer(const bf16* QI, const bf16* KI, const float* WI, float* SC, char* lds, int vcu, int G, int wave_s) {
    const int tid = opaque_tid_w(wave_s), wid = wave_s, lane = tid & 63, r32 = lane & 31, hi = lane >> 5;
    const int blk = wid & 3, kb = blk & 1, qb2 = blk >> 1, hh = wid >> 2;
    float* xl = (float*)lds;
    for (int u = vcu; u < NB * 528; u += G) {
        const int b = u / 528, rem = u - b * 528;
        int c = (int)((sqrtf(8.0f * (float)rem + 1.0f) - 1.0f) * 0.5f);
        while ((c + 1) * (c + 2) / 2 <= rem) ++c;
        while (c * (c + 1) / 2 > rem) --c;
        const int kt = rem - c * (c + 1) / 2;
        const int q0 = b * SEQ + 64 * c + 32 * qb2, s0 = b * SEQ + 64 * kt + 32 * kb;
        bf16x8 kf[8];
#pragma unroll
        for (int ks = 0; ks < 8; ++ks) kf[ks] = *(const bf16x8*)(KI + (size_t)(s0 + r32) * 128 + 16 * ks + 8 * hi);
        f32x16 sc = {};
        const bf16* qrow = QI + (size_t)(q0 + r32) * 4096 + (16 * hh) * 128 + 8 * hi;
        const float* wrow = WI + (size_t)(q0 + r32) * 32 + 16 * hh;
#pragma unroll 2
        for (int hd = 0; hd < 16; ++hd) {
            bf16x8 qf[8];
#pragma unroll
            for (int ks = 0; ks < 8; ++ks) qf[ks] = *(const bf16x8*)(qrow + hd * 128 + 16 * ks);
            const float w = wrow[hd];
            f32x16 p = {};
#pragma unroll
            for (int ks = 0; ks < 8; ++ks) p = __builtin_amdgcn_mfma_f32_32x32x16_bf16(kf[ks], qf[ks], p, 0, 0, 0);
#pragma unroll
            for (int r = 0; r < 16; ++r) sc[r] += w * fmaxf(p[r], 0.f);
        }
        if (hh == 1) {
#pragma unroll
            for (int g = 0; g < 4; ++g) *(f32x4*)(xl + (blk * 64 + lane) * 16 + 4 * g) = (f32x4){sc[4 * g], sc[4 * g + 1], sc[4 * g + 2], sc[4 * g + 3]};
        }
        __syncthreads();
        if (hh == 0) {
            float* orow = SC + (size_t)(q0 + r32) * SEQ + 64 * kt + 32 * kb + 4 * hi;
#pragma unroll
            for (int g = 0; g < 4; ++g) { const f32x4 t = *(const f32x4*)(xl + (blk * 64 + lane) * 16 + 4 * g);
                *(f32x4*)(orow + 8 * g) = (f32x4){sc[4 * g] + t[0], sc[4 * g + 1] + t[1], sc[4 * g + 2] + t[2], sc[4 * g + 3] + t[3]}; }
        }
        __syncthreads();
    }
}
__device__ __forceinline__ unsigned f2key(float f) { const unsigned u = __float_as_uint(f); return (u & 0x80000000u) ? ~u : (u | 0x80000000u); }
__device__ __forceinline__ int wave_count(int c) { int t = 0;
#pragma unroll
    for (int b = 0; b < 6; ++b) t += __builtin_popcountll(__ballot((c >> b) & 1)) << b;
    return t; }
__device__ __forceinline__ void phase_dsa_topk(const float* SC, unsigned* MASK, int gw, int ngw, int lane) {
    for (int tq = gw; tq < MT; tq += ngw) {
        const int t = tq & (SEQ - 1), n = ((t >> 6) + 1) * 64;
        unsigned key[32];
#pragma unroll
        for (int i = 0; i < 8; ++i) { const int k0 = 256 * i + 4 * lane;
            f32x4 v = (f32x4){0.f, 0.f, 0.f, 0.f}; const bool ok = k0 < n;
            if (ok) v = *(const f32x4*)(SC + (size_t)tq * SEQ + k0);
#pragma unroll
            for (int e = 0; e < 4; ++e) key[4 * i + e] = ok ? f2key(v[e]) : 0u; }
        unsigned sel = 0u;
        if (n <= 256) {
#pragma unroll
            for (int j = 0; j < 32; ++j) sel |= (key[j] != 0u ? 1u : 0u) << j;
        } else {
            unsigned thr = 0u;
            for (int bit = 31; bit >= 0; --bit) { const unsigned cand = thr | (1u << bit); int c = 0;
#pragma unroll
                for (int j = 0; j < 32; ++j) asm volatile("v_cmp_le_u32 vcc, %1, %2\n\tv_addc_co_u32 %0, vcc, 0, %0, vcc" : "+v"(c) : "s"(cand), "v"(key[j]) : "vcc");
                if (wave_count(c) >= 256) thr = cand; }
            int cg = 0, ce = 0;
#pragma unroll
            for (int j = 0; j < 32; ++j) { asm volatile("v_cmp_lt_u32 vcc, %1, %2\n\tv_addc_co_u32 %0, vcc, 0, %0, vcc" : "+v"(cg) : "s"(thr), "v"(key[j]) : "vcc");
                                           asm volatile("v_cmp_eq_u32 vcc, %1, %2\n\tv_addc_co_u32 %0, vcc, 0, %0, vcc" : "+v"(ce) : "s"(thr), "v"(key[j]) : "vcc"); }
            const int gt = wave_count(cg), eq = wave_count(ce);
            const int need = 256 - gt;
            if (eq == need) {
#pragma unroll
                for (int j = 0; j < 32; ++j) sel |= (key[j] >= thr ? 1u : 0u) << j;
            } else {
                int run = 0; const unsigned long long lt = (1ull << lane) - 1ull;
#pragma unroll
                for (int i = 0; i < 8; ++i) { int below = 0, mine = 0, tot = 0;
#pragma unroll
                    for (int e = 0; e < 4; ++e) { const unsigned long long bm = __ballot(key[4 * i + e] == thr); below += __builtin_popcountll(bm & lt); tot += __builtin_popcountll(bm); }
#pragma unroll
                    for (int e = 0; e < 4; ++e) { const bool iseq = key[4 * i + e] == thr; const int rank = run + below + mine;
                        const bool take = key[4 * i + e] > thr || (iseq && rank < need);
                        sel |= (take ? 1u : 0u) << (4 * i + e); mine += iseq ? 1 : 0; }
                    run += tot; }
            }
        }
#pragma unroll
        for (int i = 0; i < 8; ++i) { unsigned w = ((sel >> (4 * i)) & 15u) << (4 * (lane & 7));
            w |= __shfl_xor(w, 1); w |= __shfl_xor(w, 2); w |= __shfl_xor(w, 4);
            if ((lane & 7) == 0) MASK[(size_t)tq * 64 + 8 * i + (lane >> 3)] = w; }
    }
}
__device__ __forceinline__ f32x8 sload8(const float* p) { f32x8 r; asm volatile("s_load_dwordx8 %0, %1, 0x0" : "=s"(r) : "s"(p) : "memory"); return r; }
__device__ __forceinline__ void phase_rwkv_scan(const float* DEC, const float* NA, const float* BB, const float* KP, const float* RR, const float* VV, const float* GG, const float* BON,
                                                const float* lnx_w, const float* lnx_b, bf16* YG, char* lds, int vcu, int G, int wave_s) {
    const int tid = opaque_tid_w(wave_s), q = wave_s, lane = tid & 63;
    float* xbuf = (float*)lds;
    float* ybuf = (float*)(lds + 4096);
    for (int bh = vcu; bh < NB * 64; bh += G) {
        const int b = bh >> 6, h = bh & 63;
        const size_t base0 = (size_t)b * SEQ * DM + h * 64;
        float S[8];
#pragma unroll
        for (int j = 0; j < 8; ++j) S[j] = 0.f;
        const float lw = lnx_w[h * 64 + lane], lb = lnx_b[h * 64 + lane];
        f32x8 na = sload8(NA + base0 + 8 * q);
        asm volatile("s_waitcnt lgkmcnt(0)" : "+s"(na) :: "memory");
        float vv = VV[base0 + lane];
        for (int t = 0; t < SEQ; ++t) {
            const size_t off = base0 + (size_t)t * DM + 8 * q, offn = base0 + (size_t)(t + 1 < SEQ ? t + 1 : t) * DM + 8 * q;
            f32x8 w8 = sload8(DEC + off), b8 = sload8(BB + off), k8 = sload8(KP + off), r8 = sload8(RR + off), nan = sload8(NA + offn);
            const float vnext = VV[offn - 8 * q + lane];
            float sap = 0.f;
#pragma unroll
            for (int j = 0; j < 8; ++j) sap = fmaf(S[j], na[j], sap);
            xbuf[((t & 1) * 8 + q) * 64 + lane] = sap;
            __syncthreads();
            float sa = 0.f;
#pragma unroll
            for (int qq = 0; qq < 8; ++qq) sa += xbuf[((t & 1) * 8 + qq) * 64 + lane];
            asm volatile("s_waitcnt lgkmcnt(0)" : "+s"(w8), "+s"(b8), "+s"(k8), "+s"(r8), "+s"(nan) :: "memory");
            float yp = 0.f;
#pragma unroll
            for (int j = 0; j < 8; ++j) { S[j] = fmaf(S[j], w8[j], fmaf(sa, b8[j], vv * k8[j])); yp = fmaf(S[j], r8[j], yp); }
            ybuf[((((t >> 4) & 1) * 16 + (t & 15)) * 8 + q) * 64 + lane] = yp;
            if ((t & 15) == 15) {
                __syncthreads();
                const int cb = (t >> 4) & 1;
#pragma unroll
                for (int s = 0; s < 2; ++s) { const int tl = 2 * q + s, tt = (t & ~15) + tl; const size_t idx = base0 + (size_t)tt * DM + lane;
                    float y = 0.f;
#pragma unroll
                    for (int qq = 0; qq < 8; ++qq) y += ybuf[((cb * 16 + tl) * 8 + qq) * 64 + lane];
                    const float mean = wave_sum(y) * (1.0f / 64.0f), d = y - mean, var = wave_sum(d * d) * (1.0f / 64.0f);
                    const float yn = d * (1.0f / sqrtf(var + 64e-5f)) * lw + lb;
                    const float bon = BON[((size_t)b * SEQ + tt) * 64 + h];
                    const float o = (yn + bon * VV[idx]) * GG[idx];
                    ((unsigned short*)YG)[idx] = (unsigned short)(cvtpk(o, 0.f) & 0xffffu); }
            }
            na = nan; vv = vnext;
        }
        __syncthreads();
    }
}

#ifndef MK_SPLIT
#define MK_SPLIT 1
#endif
constexpr int N_PHASES = 1 + 8 * 3 - 1 + 2 * 7 + 8 + 6 + 1;
struct Args { const void* in[51]; float* out; unsigned char* ws; int ph_lo, ph_hi; };
static_assert(sizeof(Args) == 51 * 8 + 8 + 8 + 8, "Args has no padding");

template <unsigned PMASK> __global__ void __launch_bounds__(NTHR, 2) mega_fwd(Args args) {
    extern __shared__ __attribute__((aligned(16))) unsigned char lds[];
    LAS unsigned char* ldsl = (LAS unsigned char*)lds;
    const int G = gridDim.x, bx = blockIdx.x, vcu = (G % 8 == 0) ? (bx % 8) * (G / 8) + bx / 8 : bx;
    const int ngw = G * NWAVES, gthreads = G * NTHR, wave_s = __builtin_amdgcn_readfirstlane(threadIdx.x >> 6);
    for (int u = threadIdx.x; u < (LDS_BYTES - LDSCTL_OFF) / 4; u += NTHR) ((LAS unsigned*)(ldsl + LDSCTL_OFF))[u] = 0u;
    __syncthreads();
    XcdBarrier bar; bar.bar = (unsigned*)(args.ws + WS_CTL) + CW_BAR; bar.x = 0; bar.st = nullptr;
    if (!MK_SPLIT) bar = xcd_barrier_post((unsigned*)(args.ws + WS_CTL) + CW_BAR, (volatile LAS unsigned*)(ldsl + LDSCTL_OFF) + 8);
    const int lo = args.ph_lo, hi = args.ph_hi; int ph = 0;
#define PB(b) if constexpr (((PMASK) >> (b)) & 1u)
#define PH_ON() (ph >= lo && ph < hi)
#define PH_END() do { if (!MK_SPLIT && ph >= lo && ph + 1 < hi) xcd_barrier(bar); ++ph; } while (0)
#define PH_VARS const int tid = opaque_tid_w(wave_s), lane = tid & 63, wave = wave_s, gw = vcu * NWAVES + wave, gtid = vcu * NTHR + tid; \
    int zo; asm volatile("s_mov_b32 %0, 0" : "=s"(zo)); unsigned char* const ws = args.ws + zo; unsigned char* const scr = ws + WS_SCR; float* const X = args.out + zo; \
    bf16* const HN = (bf16*)(ws + WS_HN); bf16* const OB = (bf16*)(ws + WS_OB); const f32x2v* const T64 = (const f32x2v*)(ws + WS_T64); const f32x2v* const T128 = (const f32x2v*)(ws + WS_T128); \
    (void)lane; (void)gw; (void)gtid; (void)scr; (void)X; (void)HN; (void)OB; (void)T64; (void)T128;
#define INF(k) ((const float*)args.in[(k) + zo])
#define RUN_GEMM(EPI_T, EPI_OBJ, A_, B_, N_, K_) do { pg8::Gemm g_{(const pg8::bf16_t*)(A_), (const pg8::bf16_t*)(B_), MT, (N_), (K_)}; pg8::StaticOrder S_; S_.init(MT, (N_), G, bx); \
        pg8::gemm_phase<EPI_T, pg8::StaticOrder, true, true>(ldsl, g_, S_, (EPI_OBJ), wave_s); } while (0)

    if (PH_ON()) PB(0) { PH_VARS
        LAS float* cs = (LAS float*)(ldsl + wave * CVT_WAVE_BYTES);
        CvtCursor cur{gw, ngw, 0};
        for (int i = 0; i < 8; ++i) { const int L = i >> 1, j = i & 1, fb = L == 0 ? 2 : (L == 1 ? 12 : (L == 2 ? 18 : 40));
            bf16* wgu = (bf16*)(ws + WS_WFFN + (size_t)i * SZ_FFN); bf16* wdn = (bf16*)(ws + WS_WFFN + (size_t)i * SZ_FFN + SZ_WGU);
            cvt_matrix(INF(fb + 1) + (size_t)j * DM * 2 * DFF, DM, DM, 2 * DFF, DstGU{wgu}, cur, cs, lane);
            cvt_matrix(INF(fb + 2) + (size_t)j * DFF * DM, DFF, DFF, DM, DstNat{wdn, DFF, DM}, cur, cs, lane); }
        for (int m = 0; m < 2; ++m) { const int mb = m ? 44 : 6; unsigned char* wb = ws + WS_WMLA + (size_t)m * SZ_MLA;
            cvt_matrix(INF(mb + 0), DM, DM, 1600, DstNat{(bf16*)wb, DM, 1600}, cur, cs, lane);
            zero_bytes(wb + (size_t)1600 * DM * 2, (size_t)192 * DM * 2, gtid, gthreads);
            cvt_matrix(INF(mb + 2), 1024, 1024, 6144, DstUQ{(bf16*)(wb + SZ_MLA_IN)}, cur, cs, lane);
            cvt_matrix(INF(mb + 4), 512, 512, 8192, DstNat{(bf16*)(wb + SZ_MLA_IN + SZ_MLA_UQ), 512, 8192}, cur, cs, lane);
            cvt_matrix(INF(mb + 5), DM, DM, DM, DstNat{(bf16*)(wb + SZ_MLA_IN + SZ_MLA_UQ + SZ_MLA_UKV), DM, DM}, cur, cs, lane); }
        { unsigned char* wb = ws + WS_WDSA;
            cvt_matrix(INF(16), DM, DM, 10400, DstDsaIn{(bf16*)wb, (bf16*)(wb + SZ_DSA_IN)}, cur, cs, lane);
            zero_bytes(wb + SZ_DSA_IN + (size_t)160 * DM * 2, (size_t)96 * DM * 2, gtid, gthreads);
            cvt_matrix(INF(17), DM, DM, DM, DstNat{(bf16*)(wb + SZ_DSA_IN + SZ_DSA_NAR), DM, DM}, cur, cs, lane); }
        { unsigned char* wb = ws + WS_WRW;
            cvt_matrix(INF(23), DM, DM, DM, DstNat{(bf16*)(wb + RW_WR), DM, DM}, cur, cs, lane);
            cvt_matrix(INF(24), DM, DM, DM, DstNat{(bf16*)(wb + RW_WK), DM, DM}, cur, cs, lane);
            cvt_matrix(INF(25), DM, DM, DM, DstNat{(bf16*)(wb + RW_WV), DM, DM}, cur, cs, lane);
            cvt_matrix(INF(26), DM, DM, DM, DstNat{(bf16*)(wb + RW_WO), DM, DM}, cur, cs, lane);
            cvt_matrix(INF(28), DM, DM, 128, DstNat{(bf16*)(wb + RW_W1), DM, 128}, cur, cs, lane);
            zero_bytes(wb + RW_W1 + (size_t)128 * DM * 2, (size_t)128 * DM * 2, gtid, gthreads);
            cvt_matrix(INF(31), DM, DM, 128, DstNat{(bf16*)(wb + RW_A1), DM, 128}, cur, cs, lane);
            zero_bytes(wb + RW_A1 + (size_t)128 * DM * 2, (size_t)128 * DM * 2, gtid, gthreads);
            cvt_matrix(INF(33), DM, DM, 480, DstNat{(bf16*)(wb + RW_G1), DM, 480}, cur, cs, lane);
            zero_bytes(wb + RW_G1 + (size_t)480 * DM * 2, (size_t)32 * DM * 2, gtid, gthreads);
            cvt_matrix(INF(29), 128, 256, DM, DstNat{(bf16*)(wb + RW_W2), 256, DM}, cur, cs, lane);
            cvt_matrix(INF(32), 128, 256, DM, DstNat{(bf16*)(wb + RW_A2), 256, DM}, cur, cs, lane);
            cvt_matrix(INF(34), 480, 512, DM, DstNat{(bf16*)(wb + RW_G2), 512, DM}, cur, cs, lane); }
        rope_tables((const int*)args.in[1 + zo], (f32x2v*)(ws + WS_T64), (f32x2v*)(ws + WS_T128), gtid, gthreads);
        phase_rmsnorm(INF(0), INF(2), HN, X, gw, ngw, lane);
    }
    PH_END();

    for (int i = 0; i < 8; ++i) {
        const int L = i >> 1, j = i & 1, fb = L == 0 ? 2 : (L == 1 ? 12 : (L == 2 ? 18 : 40));
        if (i > 0) { if (PH_ON()) PB(1) { PH_VARS phase_rmsnorm(X, INF(fb) + j * DM, HN, nullptr, gw, ngw, lane); } PH_END(); }
        if (PH_ON()) PB(2) { PH_VARS EpiSwiglu E{(pg8::bf16_t*)(scr + SC_ACT)}; RUN_GEMM(EpiSwiglu, E, HN, ws + WS_WFFN + (size_t)i * SZ_FFN, 2 * DFF, DM); }
        PH_END();
        if (PH_ON()) PB(3) { PH_VARS EpiResid E{X, DM, 0.5f}; RUN_GEMM(EpiResid, E, scr + SC_ACT, ws + WS_WFFN + (size_t)i * SZ_FFN + SZ_WGU, DM, DFF); }
        PH_END();
        if (j == 1) continue;
        size_t wo_off;
        if (L == 0 || L == 3) {
            const int mb = L ? 44 : 6; const size_t wbo = WS_WMLA + (size_t)(L ? 1 : 0) * SZ_MLA; wo_off = wbo + SZ_MLA_IN + SZ_MLA_UQ + SZ_MLA_UKV;
            if (PH_ON()) PB(1) { PH_VARS phase_rmsnorm(X, INF(fb + 3), HN, nullptr, gw, ngw, lane); }
            PH_END();
            if (PH_ON()) PB(4) { PH_VARS EpiF32 E{(float*)(scr + ML_LAT), 1792}; RUN_GEMM(EpiF32, E, HN, ws + wbo, 1792, DM); }
            PH_END();
            if (PH_ON()) PB(5) { PH_VARS phase_mla_latnorm((const float*)(scr + ML_LAT), INF(mb + 1), INF(mb + 3), T64, (bf16*)(scr + ML_CQN), (bf16*)(scr + ML_CKV), (bf16*)(scr + ML_K), gw, ngw, lane); }
            PH_END();
            if (PH_ON()) PB(6) { PH_VARS EpiMlaQ E1{(pg8::bf16_t*)(scr + ML_Q), T64}; RUN_GEMM(EpiMlaQ, E1, scr + ML_CQN, ws + wbo + SZ_MLA_IN, 6144, 1024); }
            PH_END();
            if (PH_ON()) PB(20) { PH_VARS EpiMlaKV E2{(pg8::bf16_t*)(scr + ML_K), (pg8::bf16_t*)(scr + ML_V)}; RUN_GEMM(EpiMlaKV, E2, scr + ML_CKV, ws + wbo + SZ_MLA_IN + SZ_MLA_UQ, 8192, 512); }
            PH_END();
            if (PH_ON()) PB(7) { PH_VARS const float scale = 0.07216878364870322f;
                const bf16* Q = (const bf16*)(scr + ML_Q); const bf16* KF = (const bf16*)(scr + ML_K); const bf16* VB = (const bf16*)(scr + ML_V);
                for (int it = vcu; it < 1024; it += G) { int bh, qb; att::unit_of(it, bh, qb); const int b = bh >> 5, h = bh & 31; const size_t tok0 = (size_t)b * SEQ + 256 * qb, tokb = (size_t)b * SEQ;
                    att::attn_unit<192, 6144, 6144, 4096, false>(Q + tok0 * 6144 + h * 192, KF + tokb * 6144 + h * 192, VB + tokb * 4096 + h * 128, OB + tok0 * 4096 + h * 128,
                                                                 nullptr, qb, scale * 1.4426950408889634f, 8.0f / scale, (char*)lds, wave_s); } }
            PH_END();
        } else if (L == 1) {
            wo_off = WS_WDSA + SZ_DSA_IN + SZ_DSA_NAR;
            if (PH_ON()) PB(1) { PH_VARS phase_rmsnorm(X, INF(fb + 3), HN, nullptr, gw, ngw, lane); }
            PH_END();
            if (PH_ON()) PB(8) { PH_VARS EpiDsaIn E1{(pg8::bf16_t*)(scr + DS_Q), (pg8::bf16_t*)(scr + DS_K), (pg8::bf16_t*)(scr + DS_V), (pg8::bf16_t*)(scr + DS_QI), T64, T128}; RUN_GEMM(EpiDsaIn, E1, HN, ws + WS_WDSA, 10240, DM); }
            PH_END();
            if (PH_ON()) PB(21) { PH_VARS EpiF32 E2{(float*)(scr + DS_KIW), 256}; RUN_GEMM(EpiF32, E2, HN, ws + WS_WDSA + SZ_DSA_IN, 256, DM); }
            PH_END();
            if (PH_ON()) PB(9) { PH_VARS phase_dsa_kiw((const float*)(scr + DS_KIW), T64, (bf16*)(scr + DS_KI), (float*)(scr + DS_WI), gw, ngw, lane); }
            PH_END();
            if (PH_ON()) PB(10) { PH_VARS phase_dsa_indexer((const bf16*)(scr + DS_QI), (const bf16*)(scr + DS_KI), (const float*)(scr + DS_WI), (float*)(scr + DS_SC), (char*)lds, vcu, G, wave_s); }
            PH_END();
            if (PH_ON()) PB(11) { PH_VARS phase_dsa_topk((const float*)(scr + DS_SC), (unsigned*)(scr + DS_MASK), gw, ngw, lane); }
            PH_END();
            if (PH_ON()) PB(12) { PH_VARS const float scale = 0.08838834764831845f;
                const bf16* QD = (const bf16*)(scr + DS_Q); const bf16* KD = (const bf16*)(scr + DS_K); const bf16* VD = (const bf16*)(scr + DS_V); const unsigned* MASK = (const unsigned*)(scr + DS_MASK);
                for (int it = vcu; it < 1024; it += G) { int bh, qb; att::unit_of(it, bh, qb); const int b = bh >> 5, h = bh & 31; const size_t tok0 = (size_t)b * SEQ + 256 * qb, tokb = (size_t)b * SEQ;
                    att::attn_unit<128, 4096, 1024, 1024, true>(QD + tok0 * 4096 + h * 128, KD + tokb * 1024 + (h >> 2) * 128, VD + tokb * 1024 + (h >> 2) * 128, OB + tok0 * 4096 + h * 128,
                                                                MASK + tok0 * 64, qb, scale * 1.4426950408889634f, 8.0f / scale, (char*)lds, wave_s); } }
            PH_END();
        } else {
            wo_off = WS_WRW + RW_WO;
            constexpr size_t XS = (size_t)MT * DM;
            if (PH_ON()) PB(13) { PH_VARS phase_rwkv_mix(X, INF(fb + 3), INF(22), (bf16*)(scr + RW_XR), gw, ngw, lane); }
            PH_END();
            if (PH_ON()) PB(14) { PH_VARS const bf16* XM = (const bf16*)(scr + RW_XR); const unsigned char* wb = ws + WS_WRW;
                for (int s = 0; s < 3; ++s) { EpiF32 E{(float*)(scr + (s == 0 ? RW_R : (s == 1 ? RW_K : RW_V))), DM}; RUN_GEMM(EpiF32, E, XM + (size_t)(s == 0 ? 0 : (s == 1 ? 2 : 3)) * XS, wb + (size_t)s * SZ_SQ, DM, DM); }
                for (int s = 0; s < 3; ++s) { EpiActBf16 E{(pg8::bf16_t*)(scr + (s == 0 ? RW_TW : (s == 1 ? RW_LA : RW_SG))), s == 2 ? 512 : 256, s == 0 ? 1 : (s == 1 ? 0 : 2)};
                    RUN_GEMM(EpiActBf16, E, XM + (size_t)(s == 0 ? 1 : (s == 1 ? 4 : 5)) * XS, wb + (s == 0 ? RW_W1 : (s == 1 ? RW_A1 : RW_G1)), s == 2 ? 512 : 256, DM); }
            }
            PH_END();
            if (PH_ON()) PB(15) { PH_VARS const unsigned char* wb = ws + WS_WRW;
                for (int s = 0; s < 3; ++s) { EpiRw2 E{(float*)(scr + (s == 0 ? RW_DEC : (s == 1 ? RW_AA : RW_G))), INF(s == 0 ? 27 : 30), s};
                    RUN_GEMM(EpiRw2, E, scr + (s == 0 ? RW_TW : (s == 1 ? RW_LA : RW_SG)), wb + (s == 0 ? RW_W2 : (s == 1 ? RW_A2 : RW_G2)), DM, s == 2 ? 512 : 256); }
            }
            PH_END();
            if (PH_ON()) PB(16) { PH_VARS phase_rwkv_prep((float*)(scr + RW_K), (float*)(scr + RW_AA), (const float*)(scr + RW_R), (float*)(scr + RW_NA), (float*)(scr + RW_BON), INF(35), INF(36), INF(37), gw, ngw, lane); }
            PH_END();
            if (PH_ON()) PB(17) { PH_VARS phase_rwkv_scan((const float*)(scr + RW_DEC), (const float*)(scr + RW_NA), (const float*)(scr + RW_AA), (const float*)(scr + RW_K), (const float*)(scr + RW_R), (const float*)(scr + RW_V),
                                                         (const float*)(scr + RW_G), (const float*)(scr + RW_BON), INF(38), INF(39), OB, (char*)lds, vcu, G, wave_s); }
            PH_END();
        }
        if (PH_ON()) PB(18) { PH_VARS EpiResid E{X, DM, 1.0f}; RUN_GEMM(EpiResid, E, OB, ws + wo_off, DM, DM); }
        PH_END();
    }
    if (PH_ON()) PB(19) { PH_VARS phase_final_norm(X, INF(50), gw, ngw, lane); }
#undef PH_ON
#undef PH_END
#undef RUN_GEMM
#undef PH_VARS
#undef INF
}

#ifndef PHASE_MASK
#define PHASE_MASK 0xFFFFFFFFu
#endif
constexpr unsigned THIN_BITS = (1u << 0) | (1u << 1) | (1u << 5) | (1u << 9) | (1u << 10) | (1u << 11) | (1u << 13) | (1u << 16) | (1u << 17) | (1u << 19);
static int phase_bits(int* out) {
    int n = 0; out[n++] = 0;
    for (int i = 0; i < 8; ++i) { const int L = i >> 1, j = i & 1;
        if (i > 0) out[n++] = 1;
        out[n++] = 2; out[n++] = 3;
        if (j == 1) continue;
        if (L == 0 || L == 3) { const int b[] = {1, 4, 5, 6, 20, 7}; for (int k = 0; k < 6; ++k) out[n++] = b[k]; }
        else if (L == 1) { const int b[] = {1, 8, 21, 9, 10, 11, 12}; for (int k = 0; k < 7; ++k) out[n++] = b[k]; }
        else { const int b[] = {13, 14, 15, 16, 17}; for (int k = 0; k < 5; ++k) out[n++] = b[k]; }
        out[n++] = 18; }
    out[n++] = 19; return n;
}
typedef void (*kern_t)(Args);
static kern_t kernel_for_bit(int bit) {
    if ((THIN_BITS >> bit) & 1u) return mega_fwd<THIN_BITS>;
    switch (bit) {
        case 2: return mega_fwd<1u << 2>; case 3: return mega_fwd<1u << 3>; case 4: return mega_fwd<1u << 4>; case 6: return mega_fwd<1u << 6>; case 20: return mega_fwd<1u << 20>;
        case 7: return mega_fwd<1u << 7>; case 8: return mega_fwd<1u << 8>; case 21: return mega_fwd<1u << 21>; case 12: return mega_fwd<1u << 12>; case 14: return mega_fwd<1u << 14>;
        case 15: return mega_fwd<1u << 15>; case 18: return mega_fwd<1u << 18>; default: return nullptr; }
}
extern "C" void kernel_launch(void* const* d_in, const int* in_sizes, int n_in, void* d_out, int out_size, void* d_ws, size_t ws_size, hipStream_t stream) {
    static int grid = 0;
    if (grid == 0) {
        if (n_in != 51 || in_sizes[0] != MT * DM || out_size != MT * DM || ws_size < WS_END) {
            fprintf(stderr, "kernel_launch: unexpected shapes: n_in %d in0 %d out %d ws %zu (need %zu); nothing launched\n", n_in, n_in > 0 ? in_sizes[0] : -1, out_size, ws_size, (size_t)WS_END); grid = -1; return; }
        int dev = 0, cus = 0;
        if (hipGetDevice(&dev) != hipSuccess || hipDeviceGetAttribute(&cus, hipDeviceAttributeMultiprocessorCount, dev) != hipSuccess) { grid = -1; return; }
#if MK_SPLIT
        for (int bit = 0; bit < 22; ++bit) { kern_t k = kernel_for_bit(bit); if (k && hipFuncSetAttribute((const void*)k, hipFuncAttributeMaxDynamicSharedMemorySize, LDS_BYTES) != hipSuccess) { fprintf(stderr, "kernel_launch: hipFuncSetAttribute failed (bit %d)\n", bit); grid = -1; return; } }
#else
        if (hipFuncSetAttribute((const void*)mega_fwd<PHASE_MASK>, hipFuncAttributeMaxDynamicSharedMemorySize, LDS_BYTES) != hipSuccess) { fprintf(stderr, "kernel_launch: hipFuncSetAttribute failed\n"); grid = -1; return; }
#endif
        (void)hipGetLastError();
        grid = cus;
    }
    if (grid < 0) return;
    (void)hipMemsetAsync((char*)d_ws + WS_CTL, 0, CTL_BYTES, stream);
    Args a{};
    for (int i = 0; i < 51; ++i) a.in[i] = d_in[i];
    a.out = (float*)d_out; a.ws = (unsigned char*)d_ws;
#if MK_SPLIT
    int bits[80]; const int np = phase_bits(bits);
    for (int p = 0; p < np; ++p) { a.ph_lo = p; a.ph_hi = p + 1; kern_t k = kernel_for_bit(bits[p]); hipLaunchKernelGGL(k, dim3(grid), dim3(NTHR), LDS_BYTES, stream, a); }
#else
    a.ph_lo = 0; a.ph_hi = 1 << 30;
    hipLaunchKernelGGL(mega_fwd<PHASE_MASK>, dim3(grid), dim3(NTHR), LDS_BYTES, stream, a);
#endif
    const hipError_t le = hipPeekAtLastError();
    if (le != hipSuccess) fprintf(stderr, "kernel_launch: launch failed: %s\n", hipGetErrorName(le));
}
```

```cpp
#include <hip/hip_runtime.h>
#include <cstdio>
#include <cstdint>
__device__ __forceinline__ int opaque_tid_w(int wave_sgpr) { int t = (int)__builtin_amdgcn_mbcnt_hi(~0u, __builtin_amdgcn_mbcnt_lo(~0u, 0u)); asm volatile("" : "+v"(t)); return wave_sgpr * 64 + t; }
namespace pg8 {
#define PG8_LAS __attribute__((address_space(3)))
typedef unsigned short bf16_t;
typedef short bf16x8 __attribute__((ext_vector_type(8)));
typedef float f32x4 __attribute__((ext_vector_type(4)));
typedef unsigned u32x4 __attribute__((ext_vector_type(4)));
constexpr int BM = 256, BK = 64, HALF = 128, HTB = HALF * BK * 2  , STAGE_BYTES = 8 * HTB, NXCD = 8, WGM = 8;

__host__ __device__ __forceinline__ int lds_byte(int r, int c) { const int st = (r >> 4) * 2 + (c >> 5), rr = r & 15, cc = c & 31, ob = rr * 64 + cc * 2; return st * 1024 + (ob ^ (((ob >> 9) & 1) << 5)); }
__host__ __device__ __forceinline__ void stage_rc(int b, int& R, int& C) { const int st = b / 1024, sb = b % 1024, swz = sb ^ (((sb >> 9) & 1) << 5); R = (st >> 1) * 16 + swz / 64; C = (st & 1) * 32 + (swz % 64) / 2; }
__host__ __device__ __forceinline__ int perm32(int rho) { const int n = rho >> 4, i = rho & 15; return 8 * (i >> 2) + 4 * n + (i & 3); }

struct Unit { int pm, pn; };
struct Gemm { const bf16_t* A; const bf16_t* Bt; int M, N, K; };

struct StaticOrder {
    static constexpr int LDA = 0;
    int nM, nN, nwg, G, c;
    __host__ __device__ void init(int M, int N, int G_, int c_) { nM = M / BM; nN = N / BM; nwg = nM * nN; G = G_; c = c_; }
    __host__ __device__ bool next(int i, Unit& u) const {
        const long L = (long)i * G + c; if (L >= nwg) return false;
        int wgid = (int)L; { const int q = nwg / NXCD, r = nwg % NXCD, xcd = wgid % NXCD, off = wgid / NXCD; wgid = (xcd < r ? xcd * (q + 1) : r * (q + 1) + (xcd - r) * q) + off; }
        const int nig = WGM * nN, gid = wgid / nig, fm = gid * WGM, gsz = (nM - fm) < WGM ? (nM - fm) : WGM;
        u.pm = fm + ((wgid % nig) % gsz); u.pn = (wgid % nig) / gsz; return true;
    }
    __device__ __forceinline__ size_t a_off(const Unit&) const { return 0; }
    __device__ __forceinline__ void a_ready(const Unit&) const {}
    __device__ __forceinline__ void done(const Unit&) const {}
};
__device__ __forceinline__ unsigned cvt_pk_bf16(float lo, float hi) { unsigned r; asm volatile("v_cvt_pk_bf16_f32 %0, %1, %2" : "=v"(r) : "v"(lo), "v"(hi)); return r; }
typedef float f32x2 __attribute__((ext_vector_type(2)));
template <class Epi, class Sched, bool ALIGN_EPI = false, bool SP2 = false>
__device__ __forceinline__ void gemm_phase(PG8_LAS unsigned char* lds, const Gemm g, const Sched& S, const Epi& E, int wave_s) {
    const int tid = opaque_tid_w(wave_s), wid = wave_s, lane = tid & 63, wr = wid >> 2, wc = wid & 3, fr = lane & 15, fq = lane >> 4;
    const int K = g.K, nt = K / BK, LDA = Sched::LDA ? Sched::LDA : K;
    unsigned voffA[2], voffB[2];
#pragma unroll
    for (int i = 0; i < 2; ++i) { int R, C; stage_rc(tid * 16 + i * 8192, R, C); const int Rb = Epi::PERM ? ((R & ~31) + perm32(R & 31)) : R;
        voffA[i] = (unsigned)(R * LDA + C) * 2u; voffB[i] = (unsigned)(Rb * K + C) * 2u; }
    const size_t kstep = (size_t)(BK * 2);
    const size_t hstep = (size_t)HALF * K * 2;
    const size_t tstep = 2 * hstep;
    const size_t hstepA = (size_t)HALF * LDA * 2, tstepA = 2 * hstepA;
    const unsigned ldsw = (unsigned)wid * 1024u;
    const int aoff = lds_byte(wr * 64 + fr, fq * 8), boff = lds_byte(wc * 32 + fr, fq * 8);
#define PG8_SA(b, h) (((b) * 2 + (h)) * HTB)
#define PG8_SB(b, h) ((4 + (b) * 2 + (h)) * HTB)
#define PG8_STAGE(bufoff, gbase, voff) do { _Pragma("unroll") for (int _i = 0; _i < 2; ++_i) \
        __builtin_amdgcn_global_load_lds((const unsigned*)((const char*)(gbase) + (voff)[_i]), (PG8_LAS unsigned*)(lds + (bufoff) + ldsw + _i * 8192), 16, 0, 0); } while (0)
#define PG8_LDA(dst, b, h) do { _Pragma("unroll") for (int m = 0; m < 4; ++m) _Pragma("unroll") for (int k = 0; k < 2; ++k) dst[m][k] = *(const PG8_LAS bf16x8*)(lds + PG8_SA(b, h) + aoff + m * 2048 + k * 1024); } while (0)
#define PG8_LDB(dst, b, h) do { _Pragma("unroll") for (int n = 0; n < 2; ++n) _Pragma("unroll") for (int k = 0; k < 2; ++k) dst[n][k] = *(const PG8_LAS bf16x8*)(lds + PG8_SB(b, h) + boff + n * 2048 + k * 1024); } while (0)
#define PG8_MMA(ai, bj, At, Bt) do { __builtin_amdgcn_s_setprio(1); _Pragma("unroll") for (int m = 0; m < 4; ++m) _Pragma("unroll") for (int n = 0; n < 2; ++n) _Pragma("unroll") for (int k = 0; k < 2; ++k) \
        acc[ai][bj][m][n] = __builtin_amdgcn_mfma_f32_16x16x32_bf16(Bt[n][k], At[m][k], acc[ai][bj][m][n], 0, 0, 0); __builtin_amdgcn_s_setprio(0); } while (0)
#define PG8_WAIT_V(n) asm volatile("s_waitcnt vmcnt(" #n ")" ::: "memory")
#define PG8_WAIT_L(n) asm volatile("s_waitcnt lgkmcnt(" #n ")" ::: "memory")
#define PG8_BAR __builtin_amdgcn_s_barrier()
#define PG8_SCHED __builtin_amdgcn_sched_barrier(0)
    Unit cur, nxt; int ui = 0;
    if (!S.next(0, cur)) return;
    f32x4 acc[2][2][4][2];
#pragma unroll
    for (int a = 0; a < 2; ++a)
#pragma unroll
        for (int b = 0; b < 2; ++b)
#pragma unroll
            for (int m = 0; m < 4; ++m)
#pragma unroll
                for (int n = 0; n < 2; ++n) acc[a][b][m][n] = (f32x4){0.f, 0.f, 0.f, 0.f};
    bf16x8 At[4][2], B0[2][2], B1[2][2];
    const char* cA = (const char*)g.A + (size_t)cur.pm * tstepA + S.a_off(cur); const char* cB = (const char*)g.Bt + (size_t)cur.pn * tstep;
    S.a_ready(cur);
    if constexpr (SP2) {
        PG8_STAGE(PG8_SB(0, 0), cB, voffB); PG8_STAGE(PG8_SB(0, 1), cB + hstep, voffB); PG8_STAGE(PG8_SA(0, 0), cA, voffA); PG8_STAGE(PG8_SA(0, 1), cA + hstepA, voffA);
        if (wr == 1) PG8_BAR;
        PG8_WAIT_V(2); PG8_BAR;
        PG8_STAGE(PG8_SB(1, 0), cB + kstep, voffB); PG8_STAGE(PG8_SA(1, 0), cA + kstep, voffA); PG8_STAGE(PG8_SB(1, 1), cB + hstep + kstep, voffB);
        PG8_WAIT_V(6); PG8_BAR;
    } else {
        PG8_STAGE(PG8_SB(0, 0), cB, voffB); PG8_STAGE(PG8_SA(0, 0), cA, voffA); PG8_STAGE(PG8_SB(0, 1), cB + hstep, voffB); PG8_STAGE(PG8_SA(0, 1), cA + hstepA, voffA);
        if (wr == 1) PG8_BAR;
        PG8_WAIT_V(4); PG8_BAR;
        PG8_STAGE(PG8_SB(1, 0), cB + kstep, voffB); PG8_STAGE(PG8_SA(1, 0), cA + kstep, voffA); PG8_STAGE(PG8_SB(1, 1), cB + hstep + kstep, voffB);
        PG8_WAIT_V(6); PG8_BAR;
    }
    for (;;) {
        const bool has_next = S.next(ui + 1, nxt);
        const char* nA = has_next ? (const char*)g.A + (size_t)nxt.pm * tstepA + S.a_off(nxt) : cA; const char* nB = has_next ? (const char*)g.Bt + (size_t)nxt.pn * tstep : cB;
        for (int t = 0; t < nt; t += 2) {
            const bool last = (t == nt - 2);
            const char* a1 = cA + (size_t)(t + 1) * kstep;
            const char* a2 = last ? nA : cA + (size_t)(t + 2) * kstep; const char* b2 = last ? nB : cB + (size_t)(t + 2) * kstep;
            const char* a3 = a2 + kstep; const char* b3 = b2 + kstep;
            if (last && has_next) S.a_ready(nxt);
            if constexpr (SP2) {
            PG8_LDB(B0, 0, 0); PG8_LDB(B1, 0, 1); PG8_SCHED; PG8_LDA(At, 0, 0); PG8_STAGE(PG8_SA(1, 1), a1 + hstepA, voffA);
            PG8_WAIT_V(8); PG8_WAIT_L(0); PG8_BAR; PG8_MMA(0, 0, At, B0); PG8_MMA(0, 1, At, B1); PG8_BAR; PG8_SCHED;
            PG8_LDA(At, 0, 1); PG8_STAGE(PG8_SB(0, 0), b2, voffB); PG8_STAGE(PG8_SB(0, 1), b2 + hstep, voffB); PG8_STAGE(PG8_SA(0, 0), a2, voffA);
            PG8_WAIT_V(8); PG8_WAIT_L(0); PG8_BAR; PG8_MMA(1, 0, At, B0); PG8_MMA(1, 1, At, B1); PG8_BAR; PG8_SCHED;
            PG8_LDB(B0, 1, 0); PG8_LDB(B1, 1, 1); PG8_SCHED; PG8_LDA(At, 1, 0); PG8_STAGE(PG8_SA(0, 1), a2 + hstepA, voffA);
            PG8_WAIT_V(8); PG8_WAIT_L(0); PG8_BAR; PG8_MMA(0, 0, At, B0); PG8_MMA(0, 1, At, B1); PG8_BAR; PG8_SCHED;
            PG8_LDA(At, 1, 1); PG8_STAGE(PG8_SB(1, 0), b3, voffB); PG8_STAGE(PG8_SB(1, 1), b3 + hstep, voffB); PG8_STAGE(PG8_SA(1, 0), a3, voffA);
            PG8_WAIT_V(8); PG8_WAIT_L(0); PG8_BAR; PG8_MMA(1, 0, At, B0); PG8_MMA(1, 1, At, B1); PG8_BAR; PG8_SCHED;
            } else {
            PG8_LDB(B0, 0, 0); PG8_SCHED; PG8_LDA(At, 0, 0); PG8_STAGE(PG8_SA(1, 1), a1 + hstepA, voffA);
            PG8_WAIT_L(8); PG8_BAR; PG8_WAIT_L(0); PG8_MMA(0, 0, At, B0); PG8_BAR; PG8_SCHED;
            PG8_LDB(B1, 0, 1); PG8_STAGE(PG8_SB(0, 0), b2, voffB);
            PG8_BAR; PG8_WAIT_L(0); PG8_MMA(0, 1, At, B1); PG8_BAR;
            PG8_LDA(At, 0, 1); PG8_STAGE(PG8_SA(0, 0), a2, voffA);
            PG8_BAR; PG8_WAIT_L(0); PG8_MMA(1, 0, At, B0); PG8_BAR; PG8_SCHED;
            PG8_STAGE(PG8_SB(0, 1), b2 + hstep, voffB);
            PG8_WAIT_V(6); PG8_BAR; PG8_MMA(1, 1, At, B1); PG8_BAR;
            PG8_LDB(B0, 1, 0); PG8_SCHED; PG8_LDA(At, 1, 0); PG8_STAGE(PG8_SA(0, 1), a2 + hstepA, voffA);
            PG8_WAIT_L(8); PG8_BAR; PG8_WAIT_L(0); PG8_MMA(0, 0, At, B0); PG8_BAR; PG8_SCHED;
            PG8_LDB(B1, 1, 1); PG8_STAGE(PG8_SB(1, 0), b3, voffB);
            PG8_BAR; PG8_WAIT_L(0); PG8_MMA(0, 1, At, B1); PG8_BAR;
            PG8_LDA(At, 1, 1); PG8_STAGE(PG8_SA(1, 0), a3, voffA);
            PG8_BAR; PG8_WAIT_L(0); PG8_MMA(1, 0, At, B0); PG8_BAR; PG8_SCHED;
            PG8_STAGE(PG8_SB(1, 1), b3 + hstep, voffB);
            PG8_WAIT_V(6); PG8_BAR; PG8_MMA(1, 1, At, B1); PG8_BAR;
            }
        }
        if constexpr (ALIGN_EPI) { if (wr == 0) PG8_BAR; }
        if constexpr (!Epi::AFTER_DRAIN) { E(acc, cur, wr, wc, fr, fq); S.done(cur); }
        if (!has_next) break;
#pragma unroll
        for (int a = 0; a < 2; ++a)
#pragma unroll
            for (int b = 0; b < 2; ++b)
#pragma unroll
                for (int m = 0; m < 4; ++m)
#pragma unroll
                    for (int n = 0; n < 2; ++n) acc[a][b][m][n] = (f32x4){0.f, 0.f, 0.f, 0.f};
        cur = nxt; cA = nA; cB = nB; ++ui;
        if constexpr (ALIGN_EPI) { if (wr == 1) PG8_BAR; }
    }
    PG8_WAIT_V(0);
    if constexpr (!ALIGN_EPI) { if (wr == 0) PG8_BAR; }
    PG8_BAR;
    if constexpr (Epi::AFTER_DRAIN) { E.fused(acc, cur, wr, wc, fr, fq, lds, wid, lane); S.done(cur); }
#undef PG8_SA
#undef PG8_SB
#undef PG8_STAGE
#undef PG8_LDA
#undef PG8_LDB
#undef PG8_MMA
#undef PG8_WAIT_V
#undef PG8_WAIT_L
#undef PG8_BAR
#undef PG8_SCHED
}
}

#define GAS __attribute__((address_space(1)))
#define LAS __attribute__((address_space(3)))
typedef unsigned short bf16;
typedef unsigned v4u __attribute__((ext_vector_type(4)));
typedef float f32x4 __attribute__((ext_vector_type(4)));
typedef short bf16x8 __attribute__((ext_vector_type(8)));
typedef GAS unsigned gu32;
typedef GAS unsigned long long gu64;
#define RLX_AGENT __ATOMIC_RELAXED, __HIP_MEMORY_SCOPE_AGENT
#define LDS_WAIT() asm volatile("s_waitcnt lgkmcnt(0)" ::: "memory")
#define VM_WAIT() asm volatile("s_waitcnt vmcnt(0)" ::: "memory")
__device__ __forceinline__ unsigned long long rt() { return __builtin_amdgcn_s_memrealtime(); }
__device__ __forceinline__ unsigned f2bf(float f) { unsigned u = __builtin_bit_cast(unsigned, f); return (u + 0x7fffu + ((u >> 16) & 1u)) >> 16; }
__device__ __forceinline__ unsigned pk2(float lo, float hi) { return f2bf(lo) | (f2bf(hi) << 16); }

#define XB_TMO      128
#define XB_XCNT(j)  (256  + 64 * (j))
#define XB_XSUB(j)  (1280 + 64 * (j))
#define XB_XGEN(j)  (2304 + 64 * (j))
#define XB_TOP      3328
#define XB_TOPGEN   3392
#define XCD_BAR_WORDS 3456
#define XB_SPIN_CAP (1u << 18)

__device__ __forceinline__ unsigned xb_ld(unsigned* p)              { return __hip_atomic_load(p, __ATOMIC_RELAXED, __HIP_MEMORY_SCOPE_AGENT); }
__device__ __forceinline__ unsigned xb_add(unsigned* p, unsigned v) { return __hip_atomic_fetch_add(p, v, __ATOMIC_RELAXED, __HIP_MEMORY_SCOPE_AGENT); }
__device__ __forceinline__ unsigned xb_xcc_id() { return (unsigned)__builtin_amdgcn_s_getreg((3 << 11) | 20) & 0xFu; }
#define XB_SPIN(cond, bar) do { unsigned _sp = 0; while (cond) { __builtin_amdgcn_s_sleep(1); \
    if ((++_sp & 255u) == 0u) { if (xb_ld(&(bar)[XB_TMO])) break; if (_sp > XB_SPIN_CAP) { atomicAdd(&(bar)[XB_TMO], 1u); break; } } } } while (0)

struct XcdBarrier {
    unsigned* bar; unsigned x;
    volatile LAS unsigned* st;
};

__device__ __forceinline__ XcdBarrier xcd_barrier_post(unsigned* bar, volatile LAS unsigned* st) {
    XcdBarrier b; b.bar = bar; b.x = xb_xcc_id(); b.st = st;
    if (threadIdx.x == 0) (void)xb_add(&bar[XB_XCNT(b.x)], 1u);
    return b;
}
__device__ __forceinline__ void xcd_barrier_complete(unsigned* bar, unsigned x, unsigned& nloc, unsigned& nx) {
    const unsigned G = gridDim.x * gridDim.y * gridDim.z;
    unsigned sum, cnt, mine, sp = 0u;
    for (;;) {
        sum = 0u; cnt = 0u; mine = 0u;
#pragma unroll
        for (unsigned j = 0; j < 16; ++j) { const unsigned c = xb_ld(&bar[XB_XCNT(j)]); sum += c; cnt += (c > 0u) ? 1u : 0u; mine = (j == x) ? c : mine; }
        if (sum == G) break;
        __builtin_amdgcn_s_sleep(1);
        if ((++sp & 255u) == 0u) { if (xb_ld(&bar[XB_TMO])) break; if (sp > XB_SPIN_CAP) { atomicAdd(&bar[XB_TMO], 1u); break; } }
    }
    nloc = mine > 0u ? mine : 1u; nx = cnt > 0u ? cnt : 1u;
}

__device__ __forceinline__ void xcd_barrier(const XcdBarrier& b) {
    asm volatile("s_waitcnt vmcnt(0)" ::: "memory");
    __syncthreads();
    if (threadIdx.x == 0) {
        unsigned* bar = b.bar;
        __builtin_amdgcn_s_waitcnt(0);
        unsigned nloc = b.st[0], nx = b.st[1];
        if (nloc == 0u) { xcd_barrier_complete(bar, b.x, nloc, nx); b.st[0] = nloc; b.st[1] = nx; }
        const unsigned old = xb_add(&bar[XB_XSUB(b.x)], 1u);
        const unsigned gen = old / nloc;
        if (old + 1u == (gen + 1u) * nloc) {
            __builtin_amdgcn_fence(__ATOMIC_RELEASE, "agent");
            asm volatile("s_waitcnt vmcnt(0)" ::: "memory");
            const unsigned og = xb_add(&bar[XB_TOP], 1u);
            const unsigned tg = og / nx;
            if (og + 1u == (tg + 1u) * nx) xb_add(&bar[XB_TOPGEN], 1u);
            else XB_SPIN(xb_ld(&bar[XB_TOPGEN]) == tg, bar);
            __builtin_amdgcn_fence(__ATOMIC_ACQUIRE, "agent");
            xb_add(&bar[XB_XGEN(b.x)], 1u);
            asm volatile("s_waitcnt vmcnt(0)" ::: "memory");
        } else {
            XB_SPIN(xb_ld(&bar[XB_XGEN(b.x)]) == gen, bar);
            __builtin_amdgcn_fence(__ATOMIC_ACQUIRE, "agent");
            asm volatile("s_waitcnt vmcnt(0)" ::: "memory");
        }
    }
    __syncthreads();
}


constexpr int NB = 4, SEQ = 2048, MT = NB * SEQ, DM = 4096, DFF = 6144;
constexpr int NWAVES = 8, NTHR = 512;
typedef float f32x8 __attribute__((ext_vector_type(8)));
typedef float f32x16 __attribute__((ext_vector_type(16)));
typedef short s16x4 __attribute__((ext_vector_type(4)));
typedef float f32x2v __attribute__((ext_vector_type(2)));
typedef unsigned u32x2v __attribute__((ext_vector_type(2)));

constexpr size_t MiB = (size_t)1 << 20;
constexpr size_t WS_CTL = 0, CTL_BYTES = 2 * MiB;
constexpr size_t WS_T64 = WS_CTL + CTL_BYTES;
constexpr size_t WS_T128 = WS_T64 + (size_t)MT * 32 * 8;
constexpr size_t WS_WFFN = WS_T128 + (size_t)MT * 64 * 8;
constexpr size_t SZ_WGU = (size_t)2 * DFF * DM * 2, SZ_WDN = (size_t)DM * DFF * 2, SZ_FFN = SZ_WGU + SZ_WDN;
constexpr size_t SZ_SQ = (size_t)DM * DM * 2;
constexpr size_t WS_WMLA = WS_WFFN + 8 * SZ_FFN;
constexpr size_t SZ_MLA_IN = (size_t)1792 * 4096 * 2, SZ_MLA_UQ = (size_t)6144 * 1024 * 2, SZ_MLA_UKV = (size_t)8192 * 512 * 2;
constexpr size_t SZ_MLA = SZ_MLA_IN + SZ_MLA_UQ + SZ_MLA_UKV + SZ_SQ;
constexpr size_t WS_WDSA = WS_WMLA + 2 * SZ_MLA;
constexpr size_t SZ_DSA_IN = (size_t)10240 * 4096 * 2, SZ_DSA_NAR = (size_t)256 * 4096 * 2;
constexpr size_t SZ_DSA = SZ_DSA_IN + SZ_DSA_NAR + SZ_SQ;
constexpr size_t WS_WRW = WS_WDSA + SZ_DSA;
constexpr size_t RW_WR = 0, RW_WK = SZ_SQ, RW_WV = 2 * SZ_SQ, RW_WO = 3 * SZ_SQ, RW_W1 = 4 * SZ_SQ, RW_A1 = RW_W1 + 2 * MiB, RW_G1 = RW_A1 + 2 * MiB,
                 RW_W2 = RW_G1 + 4 * MiB, RW_A2 = RW_W2 + 2 * MiB, RW_G2 = RW_A2 + 2 * MiB, SZ_RW = RW_G2 + 4 * MiB;
constexpr size_t WS_XH = WS_WRW + SZ_RW;
constexpr size_t WS_XL = WS_XH + 64 * MiB;
constexpr size_t WS_OB = WS_XL + 64 * MiB;
constexpr size_t WS_SCR = WS_OB + 64 * MiB;
constexpr size_t SC_ACT = 0;
constexpr size_t ML_LAT = 0;
constexpr size_t ML_CQN = ML_LAT + 56 * MiB;
constexpr size_t ML_CKV = ML_CQN + 16 * MiB;
constexpr size_t ML_Q = ML_CKV + 8 * MiB;
constexpr size_t ML_K = ML_Q + 96 * MiB;
constexpr size_t ML_V = ML_K + 96 * MiB;
constexpr size_t ML_END = ML_V + 64 * MiB;
constexpr size_t DS_Q = 0;
constexpr size_t DS_K = DS_Q + 64 * MiB;
constexpr size_t DS_V = DS_K + 16 * MiB;
constexpr size_t DS_QI = DS_V + 16 * MiB;
constexpr size_t DS_KI = DS_QI + 64 * MiB;
constexpr size_t DS_WI = DS_KI + 2 * MiB;
constexpr size_t DS_SC = DS_WI + 1 * MiB;
constexpr size_t DS_KIW = DS_SC;
constexpr size_t DS_MASK = DS_SC + 64 * MiB;
constexpr size_t DS_END = DS_MASK + 2 * MiB;
constexpr size_t RW_XR = 0;
constexpr size_t RW_R = 384 * MiB;
constexpr size_t RW_K = RW_R + 128 * MiB, RW_V = RW_K + 128 * MiB;
constexpr size_t RW_DEC = RW_V + 128 * MiB, RW_AA = RW_DEC + 128 * MiB, RW_G = RW_AA + 128 * MiB;
constexpr size_t RW_TW = RW_G + 128 * MiB;
constexpr size_t RW_LA = RW_TW + 4 * MiB;
constexpr size_t RW_SG = RW_LA + 4 * MiB;
constexpr size_t RW_BON = RW_SG + 8 * MiB;
constexpr size_t RW_NA = 0;
constexpr size_t RW_END = RW_BON + 2 * MiB;
constexpr size_t SCR_BYTES_WS = RW_END > ML_END ? (RW_END > DS_END ? RW_END : DS_END) : (ML_END > DS_END ? ML_END : DS_END);
constexpr size_t WS_END = WS_SCR + SCR_BYTES_WS;
static_assert(WS_END <= (size_t)3351195648ull, "workspace map exceeds sum(inputs) bytes");
static_assert((size_t)MT * DFF * 2 <= SCR_BYTES_WS, "ACT fits");
constexpr int CW_BAR = 4096;
constexpr size_t CTL_RSQ = 65536;
constexpr int N_RSQ = 13;
static_assert((CW_BAR + XCD_BAR_WORDS) * 4 <= (int)CTL_RSQ && CTL_RSQ + (size_t)(N_RSQ + 6) * MT * 8 <= CTL_BYTES, "ctl");
constexpr float RSQ_SCALE = 1048576.0f;
#ifndef RES_LO
#define RES_LO 0
#endif
__device__ __forceinline__ float rsq_rstd(const unsigned long long* rsq, int row) { return __builtin_amdgcn_rsqf((float)rsq[row] * (1.0f / (RSQ_SCALE * DM)) + 1e-6f); }

constexpr int RING_BYTES = 131072;
constexpr int CVT_WAVE_BYTES = 64 * 65 * 4;
constexpr int LDSCTL_OFF = 155648, LDS_BYTES = 163840;
static_assert(NWAVES * CVT_WAVE_BYTES <= LDSCTL_OFF, "lds");

#define WS_DPP(x, ctrl) __builtin_bit_cast(float, __builtin_amdgcn_update_dpp(0, __builtin_bit_cast(int, (x)), (ctrl), 0xF, 0xF, true))
#define WS_DPPM(x, ctrl, rmask) __builtin_bit_cast(float, __builtin_amdgcn_update_dpp(0, __builtin_bit_cast(int, (x)), (ctrl), (rmask), 0xF, false))
__device__ __forceinline__ float row_sum16(float v) {
    v += WS_DPP(v, 0xB1); v += WS_DPP(v, 0x4E); v += WS_DPP(v, 0x141); v += WS_DPP(v, 0x140); return v; }
__device__ __forceinline__ float wave_sum(float v) {
    v = row_sum16(v);
    v += WS_DPPM(v, 0x142, 0xA);
    v += WS_DPPM(v, 0x143, 0xC);
    return __builtin_bit_cast(float, __builtin_amdgcn_readlane(__builtin_bit_cast(int, v), 63));
}
__device__ __forceinline__ unsigned cvtpk(float lo, float hi) { unsigned r; asm volatile("v_cvt_pk_bf16_f32 %0, %1, %2" : "=v"(r) : "v"(lo), "v"(hi)); return r; }
__device__ __forceinline__ float fast_exp(float x) { return __builtin_amdgcn_exp2f(x * 1.4426950408889634f); }
__device__ __forceinline__ float fast_sigmoid(float x) { return __builtin_amdgcn_rcpf(1.0f + fast_exp(-x)); }

using pg8::f32x4; using pg8::u32x4; using pg8::Unit; using pg8::BM; using pg8::HALF;

__device__ __forceinline__ u32x4 pack8(const f32x4 a, const f32x4 b) { u32x4 w; w.x = cvtpk(a[0], a[1]); w.y = cvtpk(a[2], a[3]); w.z = cvtpk(b[0], b[1]); w.w = cvtpk(b[2], b[3]); return w; }
__device__ __forceinline__ f32x4 bf_lo4(const u32x4 w, int half) { const unsigned a = half ? w.z : w.x, b = half ? w.w : w.y;
    return (f32x4){__uint_as_float(a << 16), __uint_as_float(a & 0xffff0000u), __uint_as_float(b << 16), __uint_as_float(b & 0xffff0000u)}; }
struct Rstd8 { float v[2][4]; };
__device__ __forceinline__ Rstd8 rstd8(const unsigned long long* rsq, int row0, float inv = 1.0f / (RSQ_SCALE * DM)) { unsigned long long q[2][4]; Rstd8 r;
#pragma unroll
    for (int ai = 0; ai < 2; ++ai)
#pragma unroll
        for (int m = 0; m < 4; ++m) q[ai][m] = rsq[row0 + ai * HALF + m * 16];
    asm volatile("" ::: "memory");
#pragma unroll
    for (int ai = 0; ai < 2; ++ai)
#pragma unroll
        for (int m = 0; m < 4; ++m) r.v[ai][m] = __builtin_amdgcn_rsqf((float)q[ai][m] * inv + 1e-6f);
    return r; }
struct EpiResid {
    static constexpr bool PERM = true, AFTER_DRAIN = false;
    pg8::bf16_t* XH; pg8::bf16_t* XL; unsigned long long* rsq; float scale;
    __device__ __forceinline__ void operator()(const f32x4 (&acc)[2][2][4][2], const Unit& u, int wr, int wc, int fr, int fq) const {
        const int row0 = u.pm * BM + wr * 64 + fr, col0 = u.pn * BM + wc * 32 + 8 * fq;
#pragma unroll
        for (int ai = 0; ai < 2; ++ai) {
        u32x4 hh[4][2];
#if RES_LO
        u32x4 ll[4][2];
#endif
#pragma unroll
            for (int m = 0; m < 4; ++m)
#pragma unroll
                for (int bj = 0; bj < 2; ++bj) { const size_t off = (size_t)(row0 + ai * HALF + m * 16) * DM + col0 + bj * HALF; hh[m][bj] = *(const u32x4*)(XH + off);
#if RES_LO
                    ll[m][bj] = *(const u32x4*)(XL + off);
#endif
                }
        asm volatile("" ::: "memory");
#pragma unroll
            for (int m = 0; m < 4; ++m) { const int row = row0 + ai * HALF + m * 16; const size_t off = (size_t)row * DM + col0; float ss = 0.f;
#pragma unroll
                for (int bj = 0; bj < 2; ++bj) { u32x4* ph = (u32x4*)(XH + off + bj * HALF); u32x4* pl = (u32x4*)(XL + off + bj * HALF); const u32x4 h = hh[m][bj];
#if RES_LO
                    const u32x4 l = ll[m][bj];
                    f32x4 x0 = bf_lo4(h, 0) + bf_lo4(l, 0) + acc[ai][bj][m][0] * scale, x1 = bf_lo4(h, 1) + bf_lo4(l, 1) + acc[ai][bj][m][1] * scale;
#else
                    f32x4 x0 = bf_lo4(h, 0) + acc[ai][bj][m][0] * scale, x1 = bf_lo4(h, 1) + acc[ai][bj][m][1] * scale; (void)pl;
#endif
                    ss += ((x0[0] * x0[0] + x0[1] * x0[1]) + (x0[2] * x0[2] + x0[3] * x0[3])) + ((x1[0] * x1[0] + x1[1] * x1[1]) + (x1[2] * x1[2] + x1[3] * x1[3]));
                    const u32x4 nh = pack8(x0, x1); *ph = nh;
#if RES_LO
                    *pl = pack8(x0 - bf_lo4(nh, 0), x1 - bf_lo4(nh, 1));
#endif
                }
                ss += __shfl_xor(ss, 16); ss += __shfl_xor(ss, 32);
                if (fq == 0 && scale != 0.f) atomicAdd(rsq + row, (unsigned long long)(ss * RSQ_SCALE + 0.5f)); }
        asm volatile("" ::: "memory");
        }
    }
};
struct EpiF32 {
    static constexpr bool PERM = false, AFTER_DRAIN = false;
    float* C; int ldc; const unsigned long long* rsq;
    __device__ __forceinline__ void operator()(const f32x4 (&acc)[2][2][4][2], const Unit& u, int wr, int wc, int fr, int fq) const {
        const int row0 = u.pm * BM + wr * 64 + fr, col0 = u.pn * BM + wc * 32 + 4 * fq;
        Rstd8 rq; if (rsq) rq = rstd8(rsq, row0);
#pragma unroll
        for (int ai = 0; ai < 2; ++ai)
#pragma unroll
            for (int m = 0; m < 4; ++m) { const int row = row0 + ai * HALF + m * 16; float* rowp = C + (size_t)row * ldc + col0; const float rs = rsq ? rq.v[ai][m] : 1.0f;
#pragma unroll
                for (int bj = 0; bj < 2; ++bj)
#pragma unroll
                    for (int n = 0; n < 2; ++n) *(f32x4*)(rowp + bj * HALF + n * 16) = acc[ai][bj][m][n] * rs; }
    }
};
struct EpiSwiglu {
    static constexpr bool PERM = true, AFTER_DRAIN = false;
    pg8::bf16_t* O; const unsigned long long* rsq;
    __device__ __forceinline__ void operator()(const f32x4 (&acc)[2][2][4][2], const Unit& u, int wr, int wc, int fr, int fq) const {
        const int row0 = u.pm * BM + wr * 64 + fr, col0 = u.pn * HALF + wc * 32 + 8 * fq;
        const Rstd8 rq = rstd8(rsq, row0);
#pragma unroll
        for (int ai = 0; ai < 2; ++ai)
#pragma unroll
            for (int m = 0; m < 4; ++m) { const int row = row0 + ai * HALF + m * 16; const float rs = rq.v[ai][m];
                f32x4 o[2];
#pragma unroll
                for (int n = 0; n < 2; ++n)
#pragma unroll
                    for (int j = 0; j < 4; ++j) { const float g = acc[ai][0][m][n][j] * rs, up = acc[ai][1][m][n][j] * rs; o[n][j] = g * fast_sigmoid(g) * up; }
                *(u32x4*)(O + (size_t)row * DFF + col0) = pack8(o[0], o[1]);
            }
    }
};
__device__ __forceinline__ void rope8(f32x4& a, f32x4& b, const f32x2v* tab) {
    const f32x4 t0 = *(const f32x4*)(tab), t1 = *(const f32x4*)(tab + 2);
    f32x4 ra, rb;
    ra[0] = a[0] * t0[0] - a[1] * t0[1]; ra[1] = a[1] * t0[0] + a[0] * t0[1];
    ra[2] = a[2] * t0[2] - a[3] * t0[3]; ra[3] = a[3] * t0[2] + a[2] * t0[3];
    rb[0] = b[0] * t1[0] - b[1] * t1[1]; rb[1] = b[1] * t1[0] + b[0] * t1[1];
    rb[2] = b[2] * t1[2] - b[3] * t1[3]; rb[3] = b[3] * t1[2] + b[2] * t1[3];
    a = ra; b = rb;
}
__device__ __forceinline__ void rope8v(f32x4& a, f32x4& b, const f32x4 t0, const f32x4 t1) {
    f32x4 ra, rb;
    ra[0] = a[0] * t0[0] - a[1] * t0[1]; ra[1] = a[1] * t0[0] + a[0] * t0[1];
    ra[2] = a[2] * t0[2] - a[3] * t0[3]; ra[3] = a[3] * t0[2] + a[2] * t0[3];
    rb[0] = b[0] * t1[0] - b[1] * t1[1]; rb[1] = b[1] * t1[0] + b[0] * t1[1];
    rb[2] = b[2] * t1[2] - b[3] * t1[3]; rb[3] = b[3] * t1[2] + b[2] * t1[3];
    a = ra; b = rb;
}
struct EpiMlaQ {
    static constexpr bool PERM = true, AFTER_DRAIN = false;
    pg8::bf16_t* Q; const f32x2v* t64; const unsigned long long* rsq;
    __device__ __forceinline__ void operator()(const f32x4 (&acc)[2][2][4][2], const Unit& u, int wr, int wc, int fr, int fq) const {
        const int row0 = u.pm * BM + wr * 64 + fr, cA = u.pn * BM + wc * 32 + 8 * fq, hdA = cA % 192, hdB = (cA + HALF) % 192;
        const Rstd8 rq = rstd8(rsq, row0, 1.0f / (RSQ_SCALE * 1024.0f));
        const bool ropeA = hdA >= 128, ropeB = hdB >= 128;
        const int toff = ((ropeA ? hdA : hdB) - 128) >> 1;
#pragma unroll
        for (int ai = 0; ai < 2; ++ai) {
            f32x4 T0[4], T1[4];
#pragma unroll
            for (int m = 0; m < 4; ++m) { T0[m] = (f32x4){1.f, 0.f, 1.f, 0.f}; T1[m] = T0[m];
                if (ropeA || ropeB) { const f32x2v* tr = t64 + (size_t)(row0 + ai * HALF + m * 16) * 32 + toff; T0[m] = *(const f32x4*)(tr); T1[m] = *(const f32x4*)(tr + 2); } }
            asm volatile("" ::: "memory");
#pragma unroll
            for (int m = 0; m < 4; ++m) { const int row = row0 + ai * HALF + m * 16; pg8::bf16_t* qrow = Q + (size_t)row * 6144 + cA; const float rs = rq.v[ai][m];
                f32x4 a = acc[ai][0][m][0] * rs, b = acc[ai][0][m][1] * rs;
                if (ropeA) rope8v(a, b, T0[m], T1[m]);
                *(u32x4*)(qrow) = pack8(a, b);
                f32x4 c = acc[ai][1][m][0] * rs, d = acc[ai][1][m][1] * rs;
                if (ropeB) rope8v(c, d, T0[m], T1[m]);
                *(u32x4*)(qrow + HALF) = pack8(c, d); }
            asm volatile("" ::: "memory");
        }
    }
};
struct EpiMlaKV {
    static constexpr bool PERM = true, AFTER_DRAIN = false;
    pg8::bf16_t* KF; pg8::bf16_t* VB; const unsigned long long* rsq; const pg8::bf16_t* KR;
    __device__ __forceinline__ void operator()(const f32x4 (&acc)[2][2][4][2], const Unit& u, int wr, int wc, int fr, int fq) const {
        const int row0 = u.pm * BM + wr * 64 + fr, h = u.pn, cc = wc * 32 + 8 * fq;
        const Rstd8 rq = rstd8(rsq, row0, 1.0f / (RSQ_SCALE * 512.0f));
        u32x4 kr[2][4];
        if (wc < 2) {
#pragma unroll
            for (int ai = 0; ai < 2; ++ai)
#pragma unroll
                for (int m = 0; m < 4; ++m) kr[ai][m] = *(const u32x4*)(KR + (size_t)(row0 + ai * HALF + m * 16) * 64 + cc);
        }
        asm volatile("" ::: "memory");
#pragma unroll
        for (int ai = 0; ai < 2; ++ai)
#pragma unroll
            for (int m = 0; m < 4; ++m) { const size_t row = (size_t)(row0 + ai * HALF + m * 16); const float rs = rq.v[ai][m];
                *(u32x4*)(KF + row * 6144 + h * 192 + cc) = pack8(acc[ai][0][m][0] * rs, acc[ai][0][m][1] * rs);
                *(u32x4*)(VB + row * 4096 + h * 128 + cc) = pack8(acc[ai][1][m][0] * rs, acc[ai][1][m][1] * rs); }
        if (wc < 2) {
#pragma unroll
            for (int ai = 0; ai < 2; ++ai)
#pragma unroll
                for (int m = 0; m < 4; ++m) *(u32x4*)(KF + (size_t)(row0 + ai * HALF + m * 16) * 6144 + h * 192 + 128 + cc) = kr[ai][m];
        }
    }
};
struct EpiMlaIn {
    static constexpr bool PERM = true, AFTER_DRAIN = false;
    pg8::bf16_t *CQN, *KF; const f32x2v* t64; const unsigned long long* rsqx; unsigned long long *rsqA;
    __device__ __forceinline__ void operator()(const f32x4 (&acc)[2][2][4][2], const Unit& u, int wr, int wc, int fr, int fq) const {
        const int row0 = u.pm * BM + wr * 64 + fr, pn = u.pn, cc = wc * 32 + 8 * fq;
        const Rstd8 rq = rstd8(rsqx, row0);
        if (pn < 6) {
            static_assert(ML_CKV - ML_CQN == 16 * MiB, "CKV follows CQN");
            pg8::bf16_t* base = CQN + (pn < 4 ? (size_t)0 : (size_t)(8u << 20)); const int ld = pn < 4 ? 1024 : 512, cb = (pn < 4 ? pn : pn - 4) * BM + cc; unsigned long long* rs2 = rsqA + (pn < 4 ? 0 : MT);
#pragma unroll
            for (int ai = 0; ai < 2; ++ai)
#pragma unroll
                for (int m = 0; m < 4; ++m) { const int row = row0 + ai * HALF + m * 16; const float rs = rq.v[ai][m]; pg8::bf16_t* orow = base + (size_t)row * ld + cb;
                    const f32x4 a = acc[ai][0][m][0] * rs, b = acc[ai][0][m][1] * rs, c = acc[ai][1][m][0] * rs, d = acc[ai][1][m][1] * rs;
                    *(u32x4*)(orow) = pack8(a, b); *(u32x4*)(orow + HALF) = pack8(c, d);
                    float ss = (((a[0] * a[0] + a[1] * a[1]) + (a[2] * a[2] + a[3] * a[3])) + ((b[0] * b[0] + b[1] * b[1]) + (b[2] * b[2] + b[3] * b[3])))
                             + (((c[0] * c[0] + c[1] * c[1]) + (c[2] * c[2] + c[3] * c[3])) + ((d[0] * d[0] + d[1] * d[1]) + (d[2] * d[2] + d[3] * d[3])));
                    ss += __shfl_xor(ss, 16); ss += __shfl_xor(ss, 32);
                    if (fq == 0) atomicAdd(rs2 + row, (unsigned long long)(ss * RSQ_SCALE + 0.5f)); }
        } else if (wc < 2) {
#pragma unroll
            for (int ai = 0; ai < 2; ++ai)
#pragma unroll
                for (int m = 0; m < 4; ++m) { const int row = row0 + ai * HALF + m * 16; const float rs = rq.v[ai][m];
                    f32x4 a = acc[ai][0][m][0] * rs, b = acc[ai][0][m][1] * rs;
                    rope8(a, b, t64 + (size_t)row * 32 + (cc >> 1));
                    *(u32x4*)(KF + (size_t)row * 64 + cc) = pack8(a, b); }
        }
    }
};
struct EpiDsaIn {
    static constexpr bool PERM = true, AFTER_DRAIN = false;
    pg8::bf16_t *QD, *KD, *VD, *QI; const f32x2v *t64, *t128; const unsigned long long* rsq;
    __device__ __forceinline__ void operator()(const f32x4 (&acc)[2][2][4][2], const Unit& u, int wr, int wc, int fr, int fq) const {
        const int row0 = u.pm * BM + wr * 64 + fr, pn = u.pn;
        pg8::bf16_t* base; int ld, cbase, mode;
        if (pn < 16) { base = QD; ld = 4096; cbase = pn * BM; mode = 1; }
        else if (pn < 20) { base = KD; ld = 1024; cbase = (pn - 16) * BM; mode = 1; }
        else if (pn < 24) { base = VD; ld = 1024; cbase = (pn - 20) * BM; mode = 0; }
        else { base = QI; ld = 4096; cbase = (pn - 24) * BM; mode = 2; }
        const int c0 = cbase + wc * 32 + 8 * fq, d0 = c0 & 127;
        const bool r64 = mode == 2 && d0 < 64;
        const Rstd8 rq = rstd8(rsq, row0);
        const bool roped = mode == 1 || r64;
        const f32x2v* tbase = mode == 1 ? t128 + (d0 >> 1) : t64 + (d0 >> 1); const int tld = mode == 1 ? 64 : 32;
#pragma unroll
        for (int ai = 0; ai < 2; ++ai) {
            f32x4 T0[4], T1[4];
#pragma unroll
            for (int m = 0; m < 4; ++m) { T0[m] = (f32x4){1.f, 0.f, 1.f, 0.f}; T1[m] = T0[m];
                if (roped) { const f32x2v* tr = tbase + (size_t)(row0 + ai * HALF + m * 16) * tld; T0[m] = *(const f32x4*)(tr); T1[m] = *(const f32x4*)(tr + 2); } }
            asm volatile("" ::: "memory");
#pragma unroll
            for (int m = 0; m < 4; ++m) { const int row = row0 + ai * HALF + m * 16; pg8::bf16_t* orow = base + (size_t)row * ld + c0; const float rs = rq.v[ai][m];
                f32x4 a = acc[ai][0][m][0] * rs, b = acc[ai][0][m][1] * rs, c = acc[ai][1][m][0] * rs, d = acc[ai][1][m][1] * rs;
                if (roped) { rope8v(a, b, T0[m], T1[m]); rope8v(c, d, T0[m], T1[m]); }
                if (mode == 2) {
                    pg8::bf16_t* q = QI + ((size_t)(row >> 5) * 32 + (c0 >> 7)) * 4096 + ((((d0 >> 4) * 2 + ((d0 >> 3) & 1)) * 32 + (row & 31)) * 8);
                    *(u32x4*)(q) = pack8(a, b); *(u32x4*)(q + 4096) = pack8(c, d);
                } else { *(u32x4*)(orow) = pack8(a, b); *(u32x4*)(orow + HALF) = pack8(c, d); }
            }
            asm volatile("" ::: "memory");
        }
    }
};
struct EpiRw2 {
    static constexpr bool PERM = false, AFTER_DRAIN = false;
    float* C; const float* vec; int mode;
    __device__ __forceinline__ void operator()(const f32x4 (&acc)[2][2][4][2], const Unit& u, int wr, int wc, int fr, int fq) const {
        const int row0 = u.pm * BM + wr * 64 + fr, col0 = u.pn * BM + wc * 32 + 4 * fq;
        f32x4 bvs[2][2];
#pragma unroll
        for (int bj = 0; bj < 2; ++bj)
#pragma unroll
            for (int n = 0; n < 2; ++n) { bvs[bj][n] = (f32x4){0.f, 0.f, 0.f, 0.f}; if (mode != 2) bvs[bj][n] = *(const f32x4*)(vec + col0 + bj * HALF + n * 16); }
        asm volatile("" ::: "memory");
#pragma unroll
        for (int bj = 0; bj < 2; ++bj)
#pragma unroll
            for (int n = 0; n < 2; ++n) { const int c = col0 + bj * HALF + n * 16; const f32x4 bv = bvs[bj][n];
#pragma unroll
                for (int ai = 0; ai < 2; ++ai)
#pragma unroll
                    for (int m = 0; m < 4; ++m) { f32x4 v = acc[ai][bj][m][n] + bv;
                        if (mode == 0) {
#pragma unroll
                            for (int j = 0; j < 4; ++j) { const float z = -v[j];
                                const float sp = fmaxf(z, 0.f) + __logf(1.0f + fast_exp(-fabsf(z)));
                                v[j] = fast_exp(-fast_exp(-sp - 0.5f)); }
                        } else if (mode == 1) {
#pragma unroll
                            for (int j = 0; j < 4; ++j) v[j] = fast_sigmoid(v[j]);
                        }
                        if (mode == 2) *(unsigned long long*)((pg8::bf16_t*)C + (size_t)(row0 + ai * HALF + m * 16) * DM + c) = (unsigned long long)cvtpk(v[0], v[1]) | ((unsigned long long)cvtpk(v[2], v[3]) << 32);
                        else *(f32x4*)(C + (size_t)(row0 + ai * HALF + m * 16) * DM + c) = v; }
            }
    }
};

struct JobOrder : pg8::StaticOrder {
    size_t a_stride; unsigned a_sel;
    __device__ __forceinline__ size_t a_off(const Unit& u) const { return (size_t)((a_sel >> (4 * (u.pn & 7))) & 15u) * a_stride; }
};
struct SplitKOrder {
    static constexpr int LDA = DM;
    int G, c;
    __device__ bool next(int i, Unit& u) const { const int L = i * G + c; if (L >= 32 * 8) return false; u.pm = L & 31; u.pn = L >> 5; return true; }
    __device__ __forceinline__ size_t a_off(const Unit& u) const { return (size_t)u.pn * 512 * 2; }
    __device__ __forceinline__ void a_ready(const Unit&) const {}
    __device__ __forceinline__ void done(const Unit&) const {}
};
struct EpiRwNarrow {
    static constexpr bool PERM = true, AFTER_DRAIN = false;
    pg8::bf16_t *TW;
    __device__ __forceinline__ void operator()(const f32x4 (&acc)[2][2][4][2], const Unit& u, int wr, int wc, int fr, int fq) const {
        const int row0 = u.pm * BM + wr * 64 + fr, pn = u.pn;
        pg8::bf16_t* O = TW + (size_t)(pn < 2 ? pn : 2) * (2u << 20); const int ldc = pn < 2 ? 256 : 512, cb = pn == 3 ? 256 : 0, act = pn == 0 ? 1 : (pn == 1 ? 0 : 2);
#pragma unroll
        for (int bj = 0; bj < 2; ++bj) {
            const int c0 = cb + bj * HALF + wc * 32 + 8 * fq;
#pragma unroll
            for (int ai = 0; ai < 2; ++ai)
#pragma unroll
                for (int m = 0; m < 4; ++m) { f32x4 v[2] = {acc[ai][bj][m][0], acc[ai][bj][m][1]};
                    if (act == 1) {
#pragma unroll
                        for (int n = 0; n < 2; ++n)
#pragma unroll
                            for (int j = 0; j < 4; ++j) { const float x = v[n][j], e = fast_exp(-2.0f * fabsf(x)), t = (1.0f - e) * __builtin_amdgcn_rcpf(1.0f + e); v[n][j] = x < 0.f ? -t : t; }
                    } else if (act == 2) {
#pragma unroll
                        for (int n = 0; n < 2; ++n)
#pragma unroll
                            for (int j = 0; j < 4; ++j) v[n][j] = fast_sigmoid(v[n][j]);
                    }
                    *(u32x4*)(O + (size_t)(row0 + ai * HALF + m * 16) * ldc + c0) = pack8(v[0], v[1]); }
        }
    }
};
template <class T> __device__ __forceinline__ T* uni(T* p) { const unsigned long long v = (unsigned long long)p;
    const unsigned lo = __builtin_amdgcn_readfirstlane((unsigned)v), hi = __builtin_amdgcn_readfirstlane((unsigned)(v >> 32)); return (T*)(GAS T*)(((unsigned long long)hi << 32) | lo); }
__device__ __forceinline__ int uni(int v) { return __builtin_amdgcn_readfirstlane(v); }
#define THIN_FN __device__ __noinline__

struct DstNat { bf16* base; int ld; int N;
    __device__ __forceinline__ bf16* operator()(int n, int = 0) const { if (n >= N) return nullptr;
        if (N == 1600 && n >= 1536) { const int i = n - 1536; n = 1536 + (i < 32 ? 2 * i : 2 * (i - 32) + 1); }
        return base + (size_t)n * ld; } };
struct DstGU { bf16* base;
    __device__ __forceinline__ bf16* operator()(int n, int = 0) const { const int up = n >= DFF, j = up ? n - DFF : n; return base + (size_t)(256 * (j >> 7) + 128 * up + (j & 127)) * DM; } };
struct DstUQ { bf16* base;
    __device__ __forceinline__ bf16* operator()(int n, int = 0) const { const int h = n / 192; int d = n - h * 192;
        if (d >= 128) { const int i = d - 128; d = 128 + (i < 32 ? 2 * i : 2 * (i - 32) + 1); }
        return base + (size_t)(h * 192 + d) * 1024; } };
struct DstDsaIn { bf16* main; bf16* nar;
    __device__ __forceinline__ bf16* operator()(int n, int k0 = 0) const {
        if (n >= 10400) return nullptr;
        if (n < 5120) { const int d = n & 127, dd = d < 64 ? 2 * d : 2 * (d - 64) + 1; return main + (size_t)((n & ~127) + dd) * DM; }
        if (n < 6144) return main + (size_t)n * DM;
        const size_t nk = (size_t)(k0 >> 9) * (256 * 512 - 512);
        if (n < 10368) { const int d = n & 127, dd = d < 32 ? 2 * d : (d < 64 ? 2 * (d - 32) + 1 : d);
            return n < 10240 ? main + (size_t)((n & ~127) + dd) * DM : nar + (size_t)dd * 512 + nk; }
        return nar + (size_t)(128 + n - 10368) * 512 + nk; } };

template <class Dst>
__device__ __forceinline__ void cvt_tile(const float* __restrict__ W, const float* __restrict__ gain, int Ksrc, int N, int k0, int n0, LAS float* scr, int lane, const Dst& dst) {
    const int kr = lane >> 4, nc = (lane & 15) * 4;
    f32x4 v[16];
#pragma unroll
    for (int i = 0; i < 16; ++i) { const int k = k0 + 4 * i + kr, n = n0 + nc;
        v[i] = (f32x4){0.f, 0.f, 0.f, 0.f};
        if (k < Ksrc && n < N) { v[i] = __builtin_nontemporal_load((const f32x4*)(W + (size_t)k * N + n)); if (gain) v[i] = v[i] * gain[k]; } }
#pragma unroll
    for (int i = 0; i < 16; ++i) { LAS float* s = scr + (4 * i + kr) * 65 + nc; s[0] = v[i][0]; s[1] = v[i][1]; s[2] = v[i][2]; s[3] = v[i][3]; }
    LDS_WAIT(); asm volatile("" ::: "memory");
    const int c = lane & 7;
#pragma unroll
    for (int j = 0; j < 8; ++j) { const int nl = (lane >> 3) + 8 * j; const LAS float* s = scr + (8 * c) * 65 + nl;
        v4u o; o.x = cvtpk(s[0], s[65]); o.y = cvtpk(s[2 * 65], s[3 * 65]); o.z = cvtpk(s[4 * 65], s[5 * 65]); o.w = cvtpk(s[6 * 65], s[7 * 65]);
        bf16* d = dst(n0 + nl, k0);
        if (d) *(v4u*)(d + k0 + 8 * c) = o; }
    LDS_WAIT(); asm volatile("" ::: "memory");
}
struct DstAny { int mode; bf16* base; bf16* base2; int ld; int N;
    __device__ __forceinline__ bf16* operator()(int n, int k0 = 0) const {
        if (mode == 0) return DstNat{base, ld, N}(n);
        if (mode == 1) return DstGU{base}(n);
        if (mode == 2) return DstUQ{base}(n);
        return DstDsaIn{base, base2}(n, k0); } };
THIN_FN int cvt_matrix_any(const float* W, const float* gain, int Ksrc, int Kdst, int N, int mode, bf16* base, bf16* base2, int ld, int gw, int ngw, int rot, LAS float* scr, int lane) {
    W = uni(W); gain = uni(gain); Ksrc = uni(Ksrc); Kdst = uni(Kdst); N = uni(N); mode = uni(mode); base = uni(base); base2 = uni(base2); ld = uni(ld); gw = uni(gw); ngw = uni(ngw); rot = uni(rot);
    scr = (LAS float*)(unsigned)uni((int)(unsigned)(uintptr_t)scr);
    const DstAny dst{mode, base, base2, ld, N};
    const int nnb = (N + 63) / 64, cnt = (Kdst / 64) * nnb;
    int first = gw - rot; if (first < 0) first += ngw;
    for (int it = first; it < cnt; it += ngw) { const int kb = it / nnb, nb = it - kb * nnb; cvt_tile(W, gain, Ksrc, N, kb * 64, nb * 64, scr, lane, dst); }
    return (rot + cnt) % ngw;
}
THIN_FN void zero_bytes(void* p, unsigned bytes, int gtid, int gthreads) {
    v4u* q = (v4u*)uni(p); const unsigned n = uni((int)bytes) / 16u;
    for (unsigned i = gtid; i < n; i += gthreads) q[i] = (v4u){0u, 0u, 0u, 0u};
}
__device__ __forceinline__ void sincos_acc(float ang, float& c, float& s) {
    double r = (double)ang; r -= 6.283185307179586476925 * __builtin_rint(r * 0.15915494309189533577);
    const double r2 = r * r;
    double sn = 1.0, cs = 1.0;
#pragma unroll
    for (int k = 12; k >= 1; --k) { sn = 1.0 - sn * r2 / (double)((2 * k) * (2 * k + 1)); cs = 1.0 - cs * r2 / (double)((2 * k - 1) * (2 * k)); }
    s = (float)(sn * r); c = (float)cs;
}
__device__ __forceinline__ void rope_tables(const int* pos, f32x2v* t64, f32x2v* t128, int gtid, int gthreads) {
    pos = uni(pos); t64 = uni(t64); t128 = uni(t128);
    for (int idx = gtid; idx < MT * 96; idx += gthreads) { const int tok = idx / 96, i = idx - tok * 96;
        const bool big = i >= 32; const int ii = big ? i - 32 : i;
        const double e = big ? (double)(2 * ii) / 128.0 : (double)(2 * ii) / 64.0;
        const float inv = (float)exp2(-e * 13.287712379549449);
        const float ang = (float)pos[tok] * inv;
        float c, s; sincos_acc(ang, c, s);
        (big ? t128 + (size_t)tok * 64 : t64 + (size_t)tok * 32)[ii] = (f32x2v){c, s}; }
}

__device__ __forceinline__ unsigned long long pk4(float a, float b, float c, float d) { return (unsigned long long)cvtpk(a, b) | ((unsigned long long)cvtpk(c, d) << 32); }
__device__ __forceinline__ f32x4 unpk4(unsigned long long w) { const unsigned a = (unsigned)w, b = (unsigned)(w >> 32);
    return (f32x4){__uint_as_float(a << 16), __uint_as_float(a & 0xffff0000u), __uint_as_float(b << 16), __uint_as_float(b & 0xffff0000u)}; }
THIN_FN void phase_split_x(const float* X, bf16* XH, bf16* XL, unsigned long long* rsq, int gw, int ngw, int lane) {
    X = uni(X); XH = uni(XH); XL = uni(XL); rsq = uni(rsq); gw = uni(gw); ngw = uni(ngw);
    for (int m = gw; m < MT; m += ngw) { const f32x4* xr = (const f32x4*)(X + (size_t)m * DM) + lane; float s = 0.f;
        unsigned long long* oh = (unsigned long long*)(XH + (size_t)m * DM) + lane; unsigned long long* ol = (unsigned long long*)(XL + (size_t)m * DM) + lane;
#pragma unroll
        for (int jb = 0; jb < 16; jb += 8) { f32x4 vv[8];
#pragma unroll
            for (int j = 0; j < 8; ++j) vv[j] = xr[64 * (jb + j)];
            asm volatile("" ::: "memory");
#pragma unroll
            for (int j = 0; j < 8; ++j) { const f32x4 v = vv[j]; s += (v[0] * v[0] + v[1] * v[1]) + (v[2] * v[2] + v[3] * v[3]);
                const unsigned long long h = pk4(v[0], v[1], v[2], v[3]); oh[64 * (jb + j)] = h;
#if RES_LO
                { const f32x4 r = v - unpk4(h); ol[64 * (jb + j)] = pk4(r[0], r[1], r[2], r[3]); }
#else
                (void)ol;
#endif
            }
            asm volatile("" ::: "memory"); }
        s = wave_sum(s); if (lane == 0) rsq[m] = (unsigned long long)(s * RSQ_SCALE + 0.5f); }
}
THIN_FN void phase_final_norm(const bf16* XH, const bf16* XL, const unsigned long long* rsq, float* O, const float* gain, int gw, int ngw, int lane) {
    XH = uni(XH); XL = uni(XL); rsq = uni(rsq); O = uni(O); gain = uni(gain); gw = uni(gw); ngw = uni(ngw); (void)XL;
    static_assert(RES_LO == 0, "phase_final_norm reads the bf16 residual plane only");
    for (int m = gw; m < MT; m += ngw) { const float rstd = rsq_rstd(rsq, m);
        const unsigned long long* xh = (const unsigned long long*)(XH + (size_t)m * DM) + lane;
        f32x4* orow = (f32x4*)(O + (size_t)m * DM) + lane;
#pragma unroll
        for (int jb = 0; jb < 16; jb += 8) { unsigned long long xr[8]; f32x4 g[8];
#pragma unroll
            for (int j = 0; j < 8; ++j) { xr[j] = xh[64 * (jb + j)]; g[j] = ((const f32x4*)gain + lane)[64 * (jb + j)]; }
            asm volatile("" ::: "memory");
#pragma unroll
            for (int j = 0; j < 8; ++j) orow[64 * (jb + j)] = unpk4(xr[j]) * rstd * g[j];
            asm volatile("" ::: "memory"); } }
}
THIN_FN void phase_mla_latnorm(const float* LAT, const float* qn, const float* kvn, const f32x2v* t64, bf16* CQN, bf16* CKV, bf16* KF, int gw, int ngw, int lane) {
    LAT = uni(LAT); qn = uni(qn); kvn = uni(kvn); t64 = uni(t64); CQN = uni(CQN); CKV = uni(CKV); KF = uni(KF); gw = uni(gw); ngw = uni(ngw);
    for (int m = gw; m < MT; m += ngw) { const float* lr = LAT + (size_t)m * 1792;
        f32x4 a[4], b[2]; float sa = 0.f, sb = 0.f;
#pragma unroll
        for (int j = 0; j < 4; ++j) { a[j] = ((const f32x4*)lr + lane)[64 * j]; sa += (a[j][0] * a[j][0] + a[j][1] * a[j][1]) + (a[j][2] * a[j][2] + a[j][3] * a[j][3]); }
#pragma unroll
        for (int j = 0; j < 2; ++j) { b[j] = ((const f32x4*)(lr + 1024) + lane)[64 * j]; sb += (b[j][0] * b[j][0] + b[j][1] * b[j][1]) + (b[j][2] * b[j][2] + b[j][3] * b[j][3]); }
        const float ra = 1.0f / sqrtf(wave_sum(sa) * (1.0f / 1024.0f) + 1e-6f), rb = 1.0f / sqrtf(wave_sum(sb) * (1.0f / 512.0f) + 1e-6f);
#pragma unroll
        for (int j = 0; j < 4; ++j) { const f32x4 g = ((const f32x4*)qn + lane)[64 * j];
            ((unsigned long long*)(CQN + (size_t)m * 1024) + lane)[64 * j] = pk4(a[j][0] * ra * g[0], a[j][1] * ra * g[1], a[j][2] * ra * g[2], a[j][3] * ra * g[3]); }
#pragma unroll
        for (int j = 0; j < 2; ++j) { const f32x4 g = ((const f32x4*)kvn + lane)[64 * j];
            ((unsigned long long*)(CKV + (size_t)m * 512) + lane)[64 * j] = pk4(b[j][0] * rb * g[0], b[j][1] * rb * g[1], b[j][2] * rb * g[2], b[j][3] * rb * g[3]); }
        const int i = lane & 31; const float x1 = lr[1536 + i], x2 = lr[1568 + i]; const f32x2v cs = t64[(size_t)m * 32 + i];
        const unsigned w = cvtpk(x1 * cs[0] - x2 * cs[1], x2 * cs[0] + x1 * cs[1]);
        unsigned* kr = (unsigned*)(KF + (size_t)m * 6144 + 128) + i;
#pragma unroll
        for (int hh = 0; hh < 16; ++hh) kr[(2 * hh + (lane >> 5)) * 96] = w;
    }
}
THIN_FN void phase_dsa_kiw(const float* KIW, const f32x2v* t64, bf16* KI, float* WI, int gw, int ngw, int lane) {
    KIW = uni(KIW); t64 = uni(t64); KI = uni(KI); WI = uni(WI); gw = uni(gw); ngw = uni(ngw);
    for (int m = gw; m < MT; m += ngw) { const float* r = KIW + (size_t)m * 2048;
        f32x2v x = *(const f32x2v*)(r + 2 * lane);
        float wi = lane < 32 ? r[128 + lane] : 0.f;
#pragma unroll
        for (int ks = 1; ks < 8; ++ks) { x += *(const f32x2v*)(r + ks * 256 + 2 * lane); if (lane < 32) wi += r[ks * 256 + 128 + lane]; }
        float o0 = x[0], o1 = x[1];
        if (lane < 32) { const f32x2v cs = t64[(size_t)m * 32 + lane]; o0 = x[0] * cs[0] - x[1] * cs[1]; o1 = x[1] * cs[0] + x[0] * cs[1]; }
        *(unsigned*)(KI + (size_t)(m >> 5) * 4096 + ((((lane >> 3) * 2 + ((lane >> 2) & 1)) * 32 + (m & 31)) * 8) + 2 * (lane & 3)) = cvtpk(o0, o1);
        if (lane < 32) WI[(size_t)(m >> 5) * 1024 + lane * 32 + (m & 31)] = wi * 0.015625f;
    }
}
THIN_FN void phase_rwkv_mix(const bf16* XH, const bf16* XL, const unsigned long long* rsq, const float* gain, const float* mu, bf16* XM, int gw, int ngw, int lane) {
    XH = uni(XH); XL = uni(XL); rsq = uni(rsq); gain = uni(gain); mu = uni(mu); XM = uni(XM); gw = uni(gw); ngw = uni(ngw); (void)XL;
    static_assert(RES_LO == 0, "phase_rwkv_mix reads the bf16 residual plane only");
    constexpr unsigned RPW = 4;
    for (unsigned it = gw; it < MT / RPW; it += ngw) { const unsigned m0 = it * RPW; const bool first = (m0 & (SEQ - 1)) == 0;
        float rs[RPW + 1];
        rs[0] = first ? 0.f : rsq_rstd(rsq, (int)m0 - 1);
#pragma unroll
        for (unsigned r = 0; r < RPW; ++r) rs[r + 1] = rsq_rstd(rsq, (int)(m0 + r));
#pragma unroll 1
        for (unsigned j = 0; j < 8; ++j) { const unsigned c = 8 * lane + 512 * j, e0 = m0 * DM + c;
            const f32x4 g0 = *(const f32x4*)(gain + c), g1 = *(const f32x4*)(gain + c + 4);
            u32x4 hr[RPW + 1];
            hr[0] = *(const u32x4*)(XH + (first ? e0 : e0 - DM));
#pragma unroll
            for (unsigned r = 0; r < RPW; ++r) hr[r + 1] = *(const u32x4*)(XH + (e0 + r * DM));
            f32x4 ma0 = *(const f32x4*)(mu + c), ma1 = *(const f32x4*)(mu + c + 4);
            f32x4 hc0[RPW + 1], hc1[RPW + 1];
#pragma unroll
            for (unsigned r = 0; r <= RPW; ++r) { hc0[r] = bf_lo4(hr[r], 0) * rs[r] * g0; hc1[r] = bf_lo4(hr[r], 1) * rs[r] * g1; }
#pragma unroll
            for (unsigned s = 0; s < 6; ++s) { f32x4 mb0 = ma0, mb1 = ma1;
                if (s + 1 < 6) { mb0 = *(const f32x4*)(mu + ((s + 1) * DM + c)); mb1 = *(const f32x4*)(mu + ((s + 1) * DM + c + 4)); }
#pragma unroll
                for (unsigned r = 0; r < RPW; ++r)
                    *(u32x4*)(XM + ((size_t)s * MT * DM + (e0 + r * DM))) = pack8(hc0[r + 1] + (hc0[r] - hc0[r + 1]) * ma0, hc1[r + 1] + (hc1[r] - hc1[r + 1]) * ma1);
                ma0 = mb0; ma1 = mb1; }
        }
    }
}

namespace att {
#define ATT_SBAR() __builtin_amdgcn_sched_barrier(0)
__device__ __forceinline__ int crow(int r, int hi) { return (r & 3) + 8 * (r >> 2) + 4 * hi; }
__device__ __forceinline__ int v_st(int k, int c) { const int kk = (k & ~0xC) | ((k & 4) << 1) | ((k & 8) >> 1); return ((kk >> 3) * 4 + (c >> 5)) * 512 + ((kk & 7) * 32 + (c & 31)) * 2; }
__device__ __forceinline__ int v_rd_base(int lane) { return ((lane & 3) << 3) | (((lane >> 2) & 3) << 6) | (((lane >> 4) & 1) << 5) | (((lane >> 5) & 1) << 8); }
constexpr int v_rd_off(int d0, int ks, int half) { return d0 * 512 + ks * 4096 + half * 2048; }
template <int OFF> __device__ __forceinline__ s16x4 tr_read(int vb) { s16x4 r; asm volatile("ds_read_b64_tr_b16 %0, %1 offset:%2" : "=&v"(r) : "v"(vb), "i"(OFF) : "memory"); return r; }
template <int D0> __device__ __forceinline__ void pv_one(f32x16& od, int vb, bf16x8 pa0, bf16x8 pa1, bf16x8 pa2, bf16x8 pa3) {
    const s16x4 l0 = tr_read<v_rd_off(D0, 0, 0)>(vb), h0 = tr_read<v_rd_off(D0, 0, 1)>(vb), l1 = tr_read<v_rd_off(D0, 1, 0)>(vb), h1 = tr_read<v_rd_off(D0, 1, 1)>(vb);
    const s16x4 l2 = tr_read<v_rd_off(D0, 2, 0)>(vb), h2 = tr_read<v_rd_off(D0, 2, 1)>(vb), l3 = tr_read<v_rd_off(D0, 3, 0)>(vb), h3 = tr_read<v_rd_off(D0, 3, 1)>(vb);
    asm volatile("s_waitcnt lgkmcnt(0)" ::: "memory"); ATT_SBAR();
#define ATT_PK(L, H) (bf16x8){L[0], L[1], L[2], L[3], H[0], H[1], H[2], H[3]}
    od = __builtin_amdgcn_mfma_f32_32x32x16_bf16(pa0, ATT_PK(l0, h0), od, 0, 0, 0);
    od = __builtin_amdgcn_mfma_f32_32x32x16_bf16(pa1, ATT_PK(l1, h1), od, 0, 0, 0);
    od = __builtin_amdgcn_mfma_f32_32x32x16_bf16(pa2, ATT_PK(l2, h2), od, 0, 0, 0);
    od = __builtin_amdgcn_mfma_f32_32x32x16_bf16(pa3, ATT_PK(l3, h3), od, 0, 0, 0);
#undef ATT_PK
}
__device__ __forceinline__ void pv_d0(f32x16* o, int vb, bf16x8 pa0, bf16x8 pa1, bf16x8 pa2, bf16x8 pa3) {
    pv_one<0>(o[0], vb, pa0, pa1, pa2, pa3); pv_one<1>(o[1], vb, pa0, pa1, pa2, pa3); pv_one<2>(o[2], vb, pa0, pa1, pa2, pa3); pv_one<3>(o[3], vb, pa0, pa1, pa2, pa3);
}
template <bool MASKED>
__device__ __forceinline__ void partialSM(f32x16& p0, f32x16& p1, float& m_reg, float& mn, float& alpha, float C, float THRS, bool tile_valid, u32x2v mk, int hi) {
    const float NINF = -__builtin_inff();
    if (MASKED) { const unsigned b0 = tile_valid ? (mk[0] >> (4 * hi)) : 0u, b1 = tile_valid ? (mk[1] >> (4 * hi)) : 0u;
#pragma unroll
        for (int r = 0; r < 16; ++r) { const int sh = (r & 3) + 8 * (r >> 2); p0[r] = ((b0 >> sh) & 1u) ? p0[r] : NINF; p1[r] = ((b1 >> sh) & 1u) ? p1[r] : NINF; }
    } else if (!tile_valid) {
#pragma unroll
        for (int r = 0; r < 16; ++r) { p0[r] = NINF; p1[r] = NINF; }
    }
    float pmax = p0[0];
#pragma unroll
    for (int r = 1; r < 16; ++r) pmax = fmaxf(pmax, p0[r]);
#pragma unroll
    for (int r = 0; r < 16; ++r) pmax = fmaxf(pmax, p1[r]);
    { auto rr = __builtin_amdgcn_permlane32_swap(__float_as_uint(pmax), __float_as_uint(pmax), false, false); pmax = fmaxf(__uint_as_float(rr[0]), __uint_as_float(rr[1])); }
    if (__builtin_expect(__all(pmax - m_reg <= THRS), 1)) { mn = m_reg; alpha = 1.f; }
    else { mn = fmaxf(m_reg, pmax); alpha = __builtin_amdgcn_exp2f((m_reg - mn) * C); m_reg = mn; }
    const float mnC = -mn * C;
#pragma unroll
    for (int r = 0; r < 16; ++r) p0[r] = fmaf(p0[r], C, mnC);
#pragma unroll
    for (int r = 0; r < 16; ++r) p1[r] = fmaf(p1[r], C, mnC);
#pragma unroll
    for (int r = 0; r < 16; ++r) p0[r] = __builtin_amdgcn_exp2f(p0[r]);
}
__device__ __forceinline__ void finishSM(f32x16& p0, f32x16& p1, float alpha, float& l_reg, bf16x8& pa0, bf16x8& pa1, bf16x8& pa2, bf16x8& pa3) {
#pragma unroll
    for (int r = 0; r < 16; ++r) p1[r] = __builtin_amdgcn_exp2f(p1[r]);
    float ps = 0;
#pragma unroll
    for (int r = 0; r < 16; ++r) ps += p0[r];
#pragma unroll
    for (int r = 0; r < 16; ++r) ps += p1[r];
    { auto rr = __builtin_amdgcn_permlane32_swap(__float_as_uint(ps), __float_as_uint(ps), false, false); ps = __uint_as_float(rr[0]) + __uint_as_float(rr[1]); }
    l_reg = l_reg * alpha + ps;
#define ATT_PK4(P, BASE, OUT) do { unsigned a0 = cvtpk(P[BASE + 0], P[BASE + 1]), a1 = cvtpk(P[BASE + 2], P[BASE + 3]);   \
    unsigned b0 = cvtpk(P[BASE + 4], P[BASE + 5]), b1 = cvtpk(P[BASE + 6], P[BASE + 7]);                              \
    auto r0 = __builtin_amdgcn_permlane32_swap(a0, b0, false, false); auto r1 = __builtin_amdgcn_permlane32_swap(a1, b1, false, false); \
    u32x4 w = {r0[0], r1[0], r0[1], r1[1]}; OUT = *reinterpret_cast<bf16x8*>(&w); } while (0)
    ATT_PK4(p0, 0, pa0); ATT_PK4(p0, 8, pa1); ATT_PK4(p1, 0, pa2); ATT_PK4(p1, 8, pa3);
#undef ATT_PK4
}
template <int DQK, int LDQ, int LDK, int LDV, bool MASKED>
__device__ __forceinline__ void attn_unit(const bf16* __restrict__ Qb, const bf16* __restrict__ Kh, const bf16* __restrict__ Vh, bf16* __restrict__ Ob,
                                          const unsigned* __restrict__ mask0, int qb, float C, float THRS, char* lds, int wave_s) {
    constexpr int KROW = DQK * 2, SHM_K = 64 * KROW, SHM_V = 64 * 128 * 2, NQF = DQK / 16, KCH = DQK / 8, KST = DQK / 64;
#define ATT_KSWZ(row, colB) ((row) * KROW + ((colB) ^ (((row) & 7) << 4)))
    const int tid = opaque_tid_w(wave_s), wid = wave_s, lane = tid & 63, r32 = lane & 31, hi = lane >> 5;
    char* V_lds = lds; char* K_lds = lds + 3 * SHM_V;
    float* wsf = (float*)(lds + 3 * SHM_V + 3 * SHM_K) + wid * 64; float* li_l = wsf; float* al_l = wsf + 32;
    const int NT = 4 * (qb + 1), lim = 4 * qb + (wid >> 1) + 1;
    float m_reg = -1e30f, l_reg = 0; f32x16 o[4] = {}; bf16x8 qr[NQF];
    const bf16* Qw = Qb + (size_t)(wid * 32 + r32) * LDQ + hi * 8;
#pragma unroll
    for (int d0 = 0; d0 < NQF; ++d0) qr[d0] = *(const bf16x8*)(Qw + d0 * 16);
    const unsigned* mrow = MASKED ? mask0 + (size_t)(wid * 32 + r32) * 64 : nullptr;
    int voff[2], koff[KST];
#pragma unroll
    for (int i = 0; i < 2; ++i) { const int L = (tid + 512 * i) * 16, st = L >> 9, w = (L & 511) >> 1, kk = ((st >> 2) << 3) | (w >> 5), c = ((st & 3) << 5) | (w & 31);
        const int k = (kk & ~0xC) | ((kk & 4) << 1) | ((kk & 8) >> 1); voff[i] = k * LDV + c; }
#pragma unroll
    for (int i = 0; i < KST; ++i) { const int L = (tid + 512 * i) * 16, row = L / KROW, cb = (L - row * KROW) ^ ((row & 7) << 4); koff[i] = row * LDK + (cb >> 1); }
    const int vb0 = (int)(uintptr_t)V_lds + v_rd_base(lane);
    typedef __attribute__((address_space(3))) unsigned lds_u32;
#define ATT_STAGE(k0, b) do { \
    _Pragma("unroll") for (int _i = 0; _i < 2; ++_i) __builtin_amdgcn_global_load_lds((const unsigned*)(Vh + (size_t)(k0) * LDV + voff[_i]), (lds_u32*)(V_lds + (b) * SHM_V + wid * 1024 + _i * 8192), 16, 0, 0); \
    _Pragma("unroll") for (int _i = 0; _i < KST; ++_i) __builtin_amdgcn_global_load_lds((const unsigned*)(Kh + (size_t)(k0) * LDK + koff[_i]), (lds_u32*)(K_lds + (b) * SHM_K + wid * 1024 + _i * 8192), 16, 0, 0); } while (0)
#define ATT_QKT(P0, P1, b) do { P0 = f32x16{}; P1 = f32x16{}; const char* _Ks = K_lds + (b) * SHM_K; \
    _Pragma("unroll") for (int d0 = 0; d0 < NQF; ++d0) { const int cb = (d0 * 16 + hi * 8) * 2; \
        const bf16x8 b0 = *(const bf16x8*)(_Ks + ATT_KSWZ(r32, cb)); const bf16x8 b1 = *(const bf16x8*)(_Ks + ATT_KSWZ(32 + r32, cb)); \
        P0 = __builtin_amdgcn_mfma_f32_32x32x16_bf16(b0, qr[d0], P0, 0, 0, 0); P1 = __builtin_amdgcn_mfma_f32_32x32x16_bf16(b1, qr[d0], P1, 0, 0, 0); } } while (0)
#define ATT_RESC(a) do { if (__any((a) < 1.f)) { if (hi == 0) al_l[r32] = (a); asm volatile("s_waitcnt lgkmcnt(0)" ::: "memory"); \
    _Pragma("unroll") for (int d = 0; d < 4; ++d) _Pragma("unroll") for (int r = 0; r < 16; ++r) o[d][r] *= al_l[crow(r, hi)]; } } while (0)
#define ATT_MASKW(j) (MASKED ? *(const u32x2v*)(mrow + 2 * (j)) : (u32x2v){0u, 0u})
    f32x16 p0, p1; float mn, al; bf16x8 pa0, pa1, pa2, pa3; u32x2v mk;
    constexpr int NST = 2 + KST;
    ATT_STAGE(0, 0); ATT_STAGE(64, 1);
    asm volatile("s_waitcnt vmcnt(%0) lgkmcnt(0)\n\ts_barrier" :: "n"(NST) : "memory");
    int buf = 0;
    for (int j = 0; j < NT; ++j) {
        const int b2 = buf == 0 ? 2 : buf - 1;
        mk = ATT_MASKW(j);
        if (j + 2 < NT) ATT_STAGE((j + 2) * 64, b2);
        ATT_SBAR();
        ATT_QKT(p0, p1, buf);
        partialSM<MASKED>(p0, p1, m_reg, mn, al, C, THRS, j < lim, mk, hi);
        ATT_RESC(al);
        finishSM(p0, p1, al, l_reg, pa0, pa1, pa2, pa3); ATT_SBAR();
        pv_d0(o, vb0 + buf * SHM_V, pa0, pa1, pa2, pa3);
        if (j + 2 < NT) asm volatile("s_waitcnt vmcnt(%0) lgkmcnt(0)\n\ts_barrier" :: "n"(NST) : "memory");
        else asm volatile("s_waitcnt vmcnt(0) lgkmcnt(0)\n\ts_barrier" ::: "memory");
        buf = buf == 2 ? 0 : buf + 1;
    }
    if (hi == 0) li_l[r32] = l_reg; asm volatile("s_waitcnt lgkmcnt(0)" ::: "memory");
    float rli[16];
#pragma unroll
    for (int r = 0; r < 16; ++r) rli[r] = __builtin_amdgcn_rcpf(li_l[crow(r, hi)]);
    __syncthreads();
    unsigned short* stg = (unsigned short*)(lds + wid * 8192);
#pragma unroll
    for (int r = 0; r < 16; ++r) { const int orow = crow(r, hi);
#pragma unroll
        for (int d0 = 0; d0 < 4; ++d0) stg[orow * 128 + d0 * 32 + r32] = (unsigned short)(cvtpk(o[d0][r] * rli[r], 0.f) & 0xffffu); }
    asm volatile("s_waitcnt lgkmcnt(0)" ::: "memory");
    bf16* Ow = Ob + (size_t)(wid * 32) * 4096;
#pragma unroll
    for (int i = 0; i < 8; ++i) { const int idx = lane + 64 * i, row = idx >> 4, ch = idx & 15;
        const u32x4 w = *(const u32x4*)((const char*)stg + row * 256 + ch * 16);
        *(u32x4*)(Ow + (size_t)row * 4096 + ch * 8) = w; }
    __syncthreads();
#undef ATT_STAGE
#undef ATT_QKT
#undef ATT_RESC
#undef ATT_MASKW
#undef ATT_KSWZ
}
__device__ __forceinline__ void unit_of(int it, int& bh, int& qb) { const int j = it & 255, s = it >> 8; bh = j >> 1; const int base = 2 * (j & 1) + (s >> 1); qb = (s & 1) ? 7 - base : base; }
}

__device__ __forceinline__ void phase_dsa_indexer(const bf16* QI, const bf16* KI, const float* WI, float* SC, LAS float* xl, int vcu, int G, int wave_s) {
    QI = uni(QI); KI = uni(KI); WI = uni(WI); SC = uni(SC); vcu = uni(vcu); G = uni(G); wave_s = uni(wave_s); xl = (LAS float*)(unsigned)uni((int)(unsigned)(uintptr_t)xl);
    const int tid = opaque_tid_w(wave_s), wid = wave_s, lane = tid & 63, r32 = lane & 31, hi = lane >> 5;
    const int blk = wid & 3, kb = blk & 1, qb2 = blk >> 1, hh = wid >> 2;
#define IDX_DECODE(U_, Q0_, S0_, KT_) do { const int b_ = (U_) / 528, rem_ = (U_) - b_ * 528; int c_ = (int)((sqrtf(8.0f * (float)rem_ + 1.0f) - 1.0f) * 0.5f); \
        while ((c_ + 1) * (c_ + 2) / 2 <= rem_) ++c_; while (c_ * (c_ + 1) / 2 > rem_) --c_; KT_ = rem_ - c_ * (c_ + 1) / 2; \
        Q0_ = b_ * SEQ + 64 * c_ + 32 * qb2; S0_ = b_ * SEQ + 64 * KT_ + 32 * kb; } while (0)
#define IDX_KLOAD(K_, S0_) do { _Pragma("unroll") for (int ks = 0; ks < 8; ++ks) K_[ks] = *(const bf16x8*)(KI + (size_t)((S0_) >> 5) * 4096 + ((ks * 2 + hi) * 32 + r32) * 8); } while (0)
#define IDX_QROW(Q0_) (QI + ((size_t)((Q0_) >> 5) * 32 + 16 * hh) * 4096 + (hi * 32 + r32) * 8)
#define IDX_WROW(Q0_) (WI + (size_t)((Q0_) >> 5) * 1024 + (16 * hh) * 32 + r32)
#define IDX_LOAD(Q_, W_, HD_) do { _Pragma("unroll") for (int ks = 0; ks < 8; ++ks) Q_[ks] = *(const bf16x8*)(qrow + (HD_) * 4096 + 512 * ks); W_ = wrow[(HD_) * 32]; } while (0)
#define IDX_HEAD(Q_, W_) do { f32x16 p = {}; _Pragma("unroll") for (int ks = 0; ks < 8; ++ks) p = __builtin_amdgcn_mfma_f32_32x32x16_bf16(kf[ks], Q_[ks], p, 0, 0, 0); \
        _Pragma("unroll") for (int r = 0; r < 16; ++r) sc[r] += W_ * fmaxf(p[r], 0.f); } while (0)
    const int NU = NB * 528;
    if (vcu < NU) {
        int q0, s0, kt; IDX_DECODE(vcu, q0, s0, kt);
        bf16x8 kf[8], kfn[8], qa[8], qb[8]; float wa, wb;
        IDX_KLOAD(kf, s0);
        const bf16* qrow = IDX_QROW(q0); const float* wrow = IDX_WROW(q0);
        IDX_LOAD(qa, wa, 0);
        for (int u = vcu; u < NU; u += G) {
            f32x16 sc = {};
#pragma unroll 1
            for (int hd = 0; hd < 14; hd += 2) {
                IDX_LOAD(qb, wb, hd + 1);
                IDX_HEAD(qa, wa);
                IDX_LOAD(qa, wa, hd + 2);
                IDX_HEAD(qb, wb);
            }
            IDX_LOAD(qb, wb, 15);
            IDX_HEAD(qa, wa);
            const int un = u + G < NU ? u + G : u; int q0n, s0n, ktn; IDX_DECODE(un, q0n, s0n, ktn);
            IDX_KLOAD(kfn, s0n);
            const bf16* qrow_n = IDX_QROW(q0n); const float* wrow_n = IDX_WROW(q0n);
            { const bf16* qrow_c = qrow; const float* wrow_c = wrow; qrow = qrow_n; wrow = wrow_n; IDX_LOAD(qa, wa, 0); qrow = qrow_c; wrow = wrow_c; }
            IDX_HEAD(qb, wb);
            if (hh == 1) {
#pragma unroll
                for (int g = 0; g < 4; ++g) *(LAS f32x4*)(xl + (blk * 64 + lane) * 16 + 4 * g) = (f32x4){sc[4 * g], sc[4 * g + 1], sc[4 * g + 2], sc[4 * g + 3]};
            }
            __syncthreads();
            if (hh == 0) {
                float* orow = SC + (size_t)(q0 + r32) * SEQ + 64 * kt + 32 * kb + 4 * hi;
#pragma unroll
                for (int g = 0; g < 4; ++g) { const f32x4 t = *(const LAS f32x4*)(xl + (blk * 64 + lane) * 16 + 4 * g);
                    *(f32x4*)(orow + 8 * g) = (f32x4){sc[4 * g] + t[0], sc[4 * g + 1] + t[1], sc[4 * g + 2] + t[2], sc[4 * g + 3] + t[3]}; }
            }
            __syncthreads();
#pragma unroll
            for (int ks = 0; ks < 8; ++ks) kf[ks] = kfn[ks];
            q0 = q0n; s0 = s0n; kt = ktn; qrow = qrow_n; wrow = wrow_n;
        }
    }
#undef IDX_DECODE
#undef IDX_KLOAD
#undef IDX_QROW
#undef IDX_WROW
#undef IDX_LOAD
#undef IDX_HEAD
}
__device__ __forceinline__ unsigned f2key(float f) { const unsigned u = __float_as_uint(f); return (u & 0x80000000u) ? ~u : (u | 0x80000000u); }
__device__ __forceinline__ int wave_count(int c) { int t = 0;
#pragma unroll
    for (int b = 0; b < 6; ++b) t += __builtin_popcountll(__ballot((c >> b) & 1)) << b;
    return t; }
THIN_FN void phase_dsa_topk(const float* SC, unsigned* MASK, int gw, int ngw, int lane) {
    SC = uni(SC); MASK = uni(MASK); gw = uni(gw); ngw = uni(ngw);
    for (int tq = gw; tq < MT; tq += ngw) {
        const int t = tq & (SEQ - 1), n = ((t >> 6) + 1) * 64;
        unsigned key[32];
#pragma unroll
        for (int i = 0; i < 8; ++i) { const int k0 = 256 * i + 4 * lane;
            f32x4 v = (f32x4){0.f, 0.f, 0.f, 0.f}; const bool ok = k0 < n;
            if (ok) v = *(const f32x4*)(SC + (size_t)tq * SEQ + k0);
#pragma unroll
            for (int e = 0; e < 4; ++e) key[4 * i + e] = ok ? f2key(v[e]) : 0u; }
        unsigned sel = 0u;
        if (n <= 256) {
#pragma unroll
            for (int j = 0; j < 32; ++j) sel |= (key[j] != 0u ? 1u : 0u) << j;
        } else {
            unsigned thr = 0u;
            for (int bit = 31; bit >= 0; --bit) { const unsigned cand = thr | (1u << bit); int c = 0;
#pragma unroll
                for (int j = 0; j < 32; ++j) asm volatile("v_cmp_le_u32 vcc, %1, %2\n\tv_addc_co_u32 %0, vcc, 0, %0, vcc" : "+v"(c) : "s"(cand), "v"(key[j]) : "vcc");
                if (wave_count(c) >= 256) thr = cand; }
            int cg = 0, ce = 0;
#pragma unroll
            for (int j = 0; j < 32; ++j) { asm volatile("v_cmp_lt_u32 vcc, %1, %2\n\tv_addc_co_u32 %0, vcc, 0, %0, vcc" : "+v"(cg) : "s"(thr), "v"(key[j]) : "vcc");
                                           asm volatile("v_cmp_eq_u32 vcc, %1, %2\n\tv_addc_co_u32 %0, vcc, 0, %0, vcc" : "+v"(ce) : "s"(thr), "v"(key[j]) : "vcc"); }
            const int gt = wave_count(cg), eq = wave_count(ce);
            const int need = 256 - gt;
            if (eq == need) {
#pragma unroll
                for (int j = 0; j < 32; ++j) sel |= (key[j] >= thr ? 1u : 0u) << j;
            } else {
                int run = 0; const unsigned long long lt = (1ull << lane) - 1ull;
#pragma unroll
                for (int i = 0; i < 8; ++i) { int below = 0, mine = 0, tot = 0;
#pragma unroll
                    for (int e = 0; e < 4; ++e) { const unsigned long long bm = __ballot(key[4 * i + e] == thr); below += __builtin_popcountll(bm & lt); tot += __builtin_popcountll(bm); }
#pragma unroll
                    for (int e = 0; e < 4; ++e) { const bool iseq = key[4 * i + e] == thr; const int rank = run + below + mine;
                        const bool take = key[4 * i + e] > thr || (iseq && rank < need);
                        sel |= (take ? 1u : 0u) << (4 * i + e); mine += iseq ? 1 : 0; }
                    run += tot; }
            }
        }
#pragma unroll
        for (int i = 0; i < 8; ++i) { unsigned w = ((sel >> (4 * i)) & 15u) << (4 * (lane & 7));
            w |= __shfl_xor(w, 1); w |= __shfl_xor(w, 2); w |= __shfl_xor(w, 4);
            if ((lane & 7) == 0) MASK[(size_t)tq * 64 + 8 * i + (lane >> 3)] = w; }
    }
}
#define CAS_ __attribute__((address_space(4)))
typedef const GAS float* gfp_t;
__device__ __forceinline__ gfp_t karg_in(int k) { return (gfp_t)((const CAS_ unsigned long long*)__builtin_amdgcn_kernarg_segment_ptr())[k]; }
struct BgTile { gfp_t W; int gi, goff; int Ksrc, N, k0, n0; DstAny dst; };
constexpr int BG_T_GU = 64 * 192, BG_T_DN = 96 * 64, BG_T_FFN = BG_T_GU + BG_T_DN, BG_T_MIN = 64 * 25, BG_T_UQ = 16 * 96, BG_T_UKV = 8 * 128, BG_T_WO = 64 * 64,
              BG_T_MLA = BG_T_MIN + BG_T_UQ + BG_T_UKV + BG_T_WO, BG_TOTAL = 3 * BG_T_FFN + BG_T_MLA;
__device__ __forceinline__ BgTile bg_decode(int t, unsigned char* ws) {
    BgTile d; int r, nnb;
    const bool isffn = t < 2 * BG_T_FFN || t >= 2 * BG_T_FFN + BG_T_MLA;
    if (isffn) { const int f = t < BG_T_FFN ? 0 : (t < 2 * BG_T_FFN ? 1 : 2); r = t - (f == 2 ? 2 * BG_T_FFN + BG_T_MLA : f * BG_T_FFN);
        const int i = 5 + f, L = i >> 1, j = i & 1, fb = L == 2 ? 18 : 40; unsigned char* wf = ws + WS_WFFN + (size_t)i * SZ_FFN;
        if (r < BG_T_GU) { d.W = karg_in(fb + 1) + (size_t)j * DM * 2 * DFF; d.gi = fb; d.goff = j * DM; d.Ksrc = DM; d.N = 2 * DFF; nnb = 192; d.dst = DstAny{1, (bf16*)wf, nullptr, DM, 2 * DFF}; }
        else { r -= BG_T_GU; d.W = karg_in(fb + 2) + (size_t)j * DFF * DM; d.gi = -1; d.goff = 0; d.Ksrc = DFF; d.N = DM; nnb = 64; d.dst = DstAny{0, (bf16*)(wf + SZ_WGU), nullptr, DFF, DM}; }
    } else { r = t - 2 * BG_T_FFN; unsigned char* wb = ws + WS_WMLA + SZ_MLA;
        if (r < BG_T_MIN) { d.W = karg_in(44); d.gi = 43; d.goff = 0; d.Ksrc = DM; d.N = 1600; nnb = 25; d.dst = DstAny{0, (bf16*)wb, nullptr, DM, 1600}; }
        else if (r < BG_T_MIN + BG_T_UQ) { r -= BG_T_MIN; d.W = karg_in(46); d.gi = 45; d.goff = 0; d.Ksrc = 1024; d.N = 6144; nnb = 96; d.dst = DstAny{2, (bf16*)(wb + SZ_MLA_IN), nullptr, 1024, 6144}; }
        else if (r < BG_T_MIN + BG_T_UQ + BG_T_UKV) { r -= BG_T_MIN + BG_T_UQ; d.W = karg_in(48); d.gi = 47; d.goff = 0; d.Ksrc = 512; d.N = 8192; nnb = 128; d.dst = DstAny{0, (bf16*)(wb + SZ_MLA_IN + SZ_MLA_UQ), nullptr, 512, 8192}; }
        else { r -= BG_T_MIN + BG_T_UQ + BG_T_UKV; d.W = karg_in(49); d.gi = -1; d.goff = 0; d.Ksrc = DM; d.N = DM; nnb = 64; d.dst = DstAny{0, (bf16*)(wb + SZ_MLA_IN + SZ_MLA_UQ + SZ_MLA_UKV), nullptr, DM, DM}; } }
    const int kb = r / nnb; d.k0 = kb * 64; d.n0 = (r - kb * nnb) * 64; return d;
}
__device__ __forceinline__ void bg_issue(const BgTile& d, f32x4 (&v)[16], f32x2v (&g)[8], int lane) {
    const int kr = lane >> 4, nc0 = (lane & 15) * 4, nc = d.n0 + nc0 <= d.N - 4 ? nc0 : d.N - 4 - d.n0;
    const GAS char* wb = (const GAS char*)(d.W + (size_t)d.k0 * d.N + d.n0);
    const unsigned rowb = (unsigned)d.N * 4u, off0 = (unsigned)(2 * kr) * rowb + (unsigned)nc * 4u;
#pragma unroll
    for (int i = 0; i < 8; ++i)
#pragma unroll
        for (int e = 0; e < 2; ++e) v[2 * i + e] = __builtin_nontemporal_load((const GAS f32x4*)(wb + (off0 + (unsigned)(8 * i + e) * rowb)));
    { const bool hg = d.gi >= 0; const GAS char* gb = (const GAS char*)(karg_in(hg ? d.gi : 0) + (hg ? d.goff : 0) + d.k0); const unsigned go = (unsigned)(2 * kr) * 4u;
#pragma unroll
        for (int i = 0; i < 8; ++i) g[i] = *(const GAS f32x2v*)(gb + (go + 32u * i)); }
}
__device__ __forceinline__ void bg_finish(const BgTile& d, bf16* dstp, int ld, const f32x4 (&v)[16], const f32x2v (&g)[8], LAS unsigned* scr, int lane) {
    const int kr = lane >> 4, nc = (lane & 15) * 4;
    LAS unsigned* sw = scr + nc * 33 + kr;
    const bool hg = d.gi >= 0;
#pragma unroll
    for (int i = 0; i < 8; ++i) { const f32x4 a = v[2 * i] * (hg ? g[i][0] : 1.0f), b = v[2 * i + 1] * (hg ? g[i][1] : 1.0f);
#pragma unroll
        for (int e = 0; e < 4; ++e) sw[e * 33 + 4 * i] = cvtpk(a[e], b[e]); }
    LDS_WAIT(); asm volatile("" ::: "memory");
    const int c = lane & 7, nl0 = lane >> 3; const LAS unsigned* sr = scr + nl0 * 33 + 4 * c;
#pragma unroll
    for (int j = 0; j < 8; ++j) { const LAS unsigned* s = sr + j * (8 * 33);
        const v4u o = (v4u){s[0], s[1], s[2], s[3]};
        if (dstp && d.dst.mode < 2 && !(d.N == 1600 && d.n0 == 1536)) *(GAS v4u*)((GAS char*)dstp + ((unsigned)(nl0 + 8 * j) * (unsigned)ld + 8u * c) * 2u) = o;
        else { bf16* dp = d.dst(d.n0 + nl0 + 8 * j, d.k0); if (dp) *(v4u*)(dp + d.k0 + 8 * c) = o; } }
    LDS_WAIT(); asm volatile("" ::: "memory");
}
__device__ __forceinline__ BgTile ffn_decode(int i, int r, unsigned char* ws) {
    BgTile d; int nnb; const int L = i >> 1, j = i & 1, fb = L == 0 ? 2 : (L == 1 ? 12 : (L == 2 ? 18 : 40)); unsigned char* wf = ws + WS_WFFN + (size_t)i * SZ_FFN;
    if (r < BG_T_GU) { d.W = karg_in(fb + 1) + (size_t)j * DM * 2 * DFF; d.gi = fb; d.goff = j * DM; d.Ksrc = DM; d.N = 2 * DFF; nnb = 192; d.dst = DstAny{1, (bf16*)wf, nullptr, DM, 2 * DFF}; }
    else { r -= BG_T_GU; d.W = karg_in(fb + 2) + (size_t)j * DFF * DM; d.gi = -1; d.goff = 0; d.Ksrc = DFF; d.N = DM; nnb = 64; d.dst = DstAny{0, (bf16*)(wf + SZ_WGU), nullptr, DFF, DM}; }
    const int kb = r / nnb; d.k0 = kb * 64; d.n0 = (r - kb * nnb) * 64; return d;
}
constexpr int MX_T_DSA_IN = 64 * 163, MX_T_SQ = 64 * 64;
__device__ __forceinline__ BgTile mix_decode(int L, int t, unsigned char* ws) {
    BgTile d; int r = t, nnb; d.goff = 0;
    if (L == 0) { unsigned char* wb = ws + WS_WMLA;
        if (r < BG_T_MIN) { d.W = karg_in(6); d.gi = 5; d.Ksrc = DM; d.N = 1600; nnb = 25; d.dst = DstAny{0, (bf16*)wb, nullptr, DM, 1600}; }
        else if (r < BG_T_MIN + BG_T_UQ) { r -= BG_T_MIN; d.W = karg_in(8); d.gi = 7; d.Ksrc = 1024; d.N = 6144; nnb = 96; d.dst = DstAny{2, (bf16*)(wb + SZ_MLA_IN), nullptr, 1024, 6144}; }
        else if (r < BG_T_MIN + BG_T_UQ + BG_T_UKV) { r -= BG_T_MIN + BG_T_UQ; d.W = karg_in(10); d.gi = 9; d.Ksrc = 512; d.N = 8192; nnb = 128; d.dst = DstAny{0, (bf16*)(wb + SZ_MLA_IN + SZ_MLA_UQ), nullptr, 512, 8192}; }
        else { r -= BG_T_MIN + BG_T_UQ + BG_T_UKV; d.W = karg_in(11); d.gi = -1; d.Ksrc = DM; d.N = DM; nnb = 64; d.dst = DstAny{0, (bf16*)(wb + SZ_MLA_IN + SZ_MLA_UQ + SZ_MLA_UKV), nullptr, DM, DM}; }
    } else if (L == 1) { unsigned char* wb = ws + WS_WDSA;
        if (r < MX_T_DSA_IN) { d.W = karg_in(16); d.gi = 15; d.Ksrc = DM; d.N = 10400; nnb = 163; d.dst = DstAny{3, (bf16*)wb, (bf16*)(wb + SZ_DSA_IN), DM, 10400}; }
        else { r -= MX_T_DSA_IN; d.W = karg_in(17); d.gi = -1; d.Ksrc = DM; d.N = DM; nnb = 64; d.dst = DstAny{0, (bf16*)(wb + SZ_DSA_IN + SZ_DSA_NAR), nullptr, DM, DM}; }
    } else { const int k = r >> 12; r &= 4095; d.W = karg_in(23 + k); d.gi = -1; d.Ksrc = DM; d.N = DM; nnb = 64; d.dst = DstAny{0, (bf16*)(ws + WS_WRW + (size_t)k * SZ_SQ), nullptr, DM, DM}; }
    const int kb = r / nnb; d.k0 = kb * 64; d.n0 = (r - kb * nnb) * 64; return d;
}
template <bool FFN>
__device__ __forceinline__ void cvt_list_pipelined(int i, unsigned char* ws, int gw, int ngw, LAS unsigned* scr, int lane) {
    const int cnt = FFN ? BG_T_FFN : (i == 0 ? BG_T_MLA : (i == 1 ? MX_T_DSA_IN + MX_T_SQ : 4 * MX_T_SQ));
#define CL_DEC(T_) (FFN ? ffn_decode(i, (T_), ws) : mix_decode(i, (T_), ws))
#define CL_FIN(D_, V_, G_) bg_finish(D_, D_.dst(D_.n0) + D_.k0, D_.dst.ld, V_, G_, scr, lane)
    f32x4 va[16], vb[16]; f32x2v ga[8], gb[8];
    int t = gw; if (t >= cnt) return;
    { const BgTile d = CL_DEC(t); bg_issue(d, va, ga, lane); }
    while (true) {
        const int t2 = t + ngw; { const BgTile d = CL_DEC(t2 < cnt ? t2 : t); bg_issue(d, vb, gb, lane); }
        { const BgTile d = CL_DEC(t); CL_FIN(d, va, ga); }
        if (t2 >= cnt) break;
        const int t3 = t2 + ngw; { const BgTile d = CL_DEC(t3 < cnt ? t3 : t2); bg_issue(d, va, ga, lane); }
        { const BgTile d = CL_DEC(t2); CL_FIN(d, vb, gb); }
        if (t3 >= cnt) break;
        t = t3;
    }
#undef CL_DEC
#undef CL_FIN
}
__device__ __forceinline__ void phase_rwkv_scan(const unsigned char* scr, unsigned char* ws, const float* k_k, const float* k_a, const float* r_k, const float* lnx_w, const float* lnx_b, bf16* YG, LAS float* ldsf, int vcu, int G, int wave_s) {
    constexpr int TC = 16, NCH = SEQ / TC, STEPF = 6 * 64, CHF = TC * STEPF;
    const int tid = opaque_tid_w(wave_s), w = wave_s, lane = tid & 63;
    LAS float* stage = ldsf;
    LAS float* ybuf = ldsf + 3 * CHF;
    LAS float* bonb = ybuf + 2 * TC * 64;
    LAS unsigned* bgs = (LAS unsigned*)(ldsf + 3 * CHF + 2 * TC * 64 + 64) + w * (64 * 33);
    static_assert((3 * CHF + 2 * TC * 64 + 64 + NWAVES * 64 * 33) * 4 <= LDSCTL_OFF, "scan LDS map");
    const unsigned short* const GG = (const unsigned short*)(scr + RW_G);
    const bool rec = w < 4, bgw = w >= 6; const int hw = w & 3, sh = w & 1;
    const int bg_gw = vcu * 2 + sh, bg_ngw = G * 2; int bg_n = 0;
    const int t2 = sh * 64 + lane, stl = t2 >> 4, c4 = t2 & 15;
    const size_t goffs = ((size_t)stl * DM + 4 * c4) * 4; const int lo0 = stl * STEPF + 4 * c4;
    const int rp = lane >> 3, kq = lane & 7, row = 16 * hw + 2 * rp;
    if (rec) __builtin_amdgcn_s_setprio(2);
    for (int bh = vcu; bh < NB * 64; bh += G) {
        const int b = bh >> 6, h = bh & 63;
        const size_t base0 = (size_t)b * SEQ * DM + h * 64;
        const unsigned char* gb = scr + base0 * 4 + goffs;
        const f32x4 kk4 = *(const f32x4*)(k_k + h * 64 + 4 * c4), ka4 = *(const f32x4*)(k_a + h * 64 + 4 * c4), rk4 = *(const f32x4*)(r_k + h * 64 + 4 * c4);
        f32x2v S0[4], S1[4];
#pragma unroll
        for (int i = 0; i < 4; ++i) { S0[i] = (f32x2v){0.f, 0.f}; S1[i] = (f32x2v){0.f, 0.f}; }
        const float lw = lnx_w[h * 64 + lane], lb = lnx_b[h * 64 + lane];
        f32x4 pre[2][5];
#define RW_LOAD(CH) do { _Pragma("unroll") for (int j_ = 0; j_ < 2; ++j_) { const size_t co_ = ((size_t)(CH) * TC + 8 * j_) * DM * 4; \
                         pre[j_][0] = *(const f32x4*)(gb + RW_K + co_); pre[j_][1] = *(const f32x4*)(gb + RW_AA + co_); pre[j_][2] = *(const f32x4*)(gb + RW_R + co_); \
                         pre[j_][3] = *(const f32x4*)(gb + RW_DEC + co_); pre[j_][4] = *(const f32x4*)(gb + RW_V + co_); } } while (0)
#define RW_PUT(CB) do { _Pragma("unroll") for (int j_ = 0; j_ < 2; ++j_) { LAS float* sb_ = stage + (CB) * CHF + lo0 + 8 * j_ * STEPF; const f32x4 kr = pre[j_][0] * kk4; \
            const float ss = row_sum16((kr[0] * kr[0] + kr[1] * kr[1]) + (kr[2] * kr[2] + kr[3] * kr[3])); const f32x4 kkv = kr * __builtin_amdgcn_rsqf(fmaxf(ss, 1e-24f));     \
            const f32x4 kp = pre[j_][0] * ((pre[j_][1] - 1.0f) * ka4 + 1.0f); const f32x4 rkp = pre[j_][2] * kp * rk4; const float bon = row_sum16((rkp[0] + rkp[1]) + (rkp[2] + rkp[3])); \
            *(LAS f32x4*)(sb_) = -kkv; *(LAS f32x4*)(sb_ + 128) = kkv * pre[j_][1]; *(LAS f32x4*)(sb_ + 192) = kp; *(LAS f32x4*)(sb_ + 256) = pre[j_][2]; if (c4 == 0) bonb[(CB) * TC + stl + 8 * j_] = bon; \
            *(LAS f32x4*)(sb_ + 64) = pre[j_][3]; *(LAS f32x4*)(sb_ + 320) = pre[j_][4]; } } while (0)
        const int ps2 = lane >> 3, pg = lane & 7, ptl = 8 * sh + ps2;
        const f32x4 lw0 = *(const f32x4*)(lnx_w + h * 64 + 8 * pg), lw1 = *(const f32x4*)(lnx_w + h * 64 + 8 * pg + 4), lb0 = *(const f32x4*)(lnx_b + h * 64 + 8 * pg), lb1 = *(const f32x4*)(lnx_b + h * 64 + 8 * pg + 4);
        u32x4 gq = {0u, 0u, 0u, 0u};
#define RW_GLOAD(CC) do { gq = *(const u32x4*)(GG + base0 + (size_t)((CC) * TC + ptl) * DM + 8 * pg); } while (0)
#define RW_POST(CC, ST_) do { const int cc_ = (CC), cbp_ = cc_ & 1, sbp_ = cc_ % 3; const size_t idx = base0 + (size_t)(cc_ * TC + ptl) * DM + 8 * pg; \
            const LAS float* yp_ = ybuf + (cbp_ * TC + ptl) * 64 + 8 * pg; const f32x4 y0 = *(const LAS f32x4*)(yp_), y1 = *(const LAS f32x4*)(yp_ + 4); \
            float sm = ((y0[0] + y0[1]) + (y0[2] + y0[3])) + ((y1[0] + y1[1]) + (y1[2] + y1[3])); \
            sm += WS_DPP(sm, 0xB1); sm += WS_DPP(sm, 0x4E); sm += WS_DPP(sm, 0x141); \
            const float mean = sm * (1.0f / 64.0f); const f32x4 d0 = y0 - mean, d1 = y1 - mean; \
            float sq = ((d0[0] * d0[0] + d0[1] * d0[1]) + (d0[2] * d0[2] + d0[3] * d0[3])) + ((d1[0] * d1[0] + d1[1] * d1[1]) + (d1[2] * d1[2] + d1[3] * d1[3])); \
            sq += WS_DPP(sq, 0xB1); sq += WS_DPP(sq, 0x4E); sq += WS_DPP(sq, 0x141); \
            const float rstd = __builtin_amdgcn_rsqf(sq * (1.0f / 64.0f) + 64e-5f), bon = bonb[sbp_ * TC + ptl]; \
            const LAS float* vp_ = stage + sbp_ * CHF + ptl * STEPF + 320 + 8 * pg; const f32x4 v0 = *(const LAS f32x4*)(vp_), v1 = *(const LAS f32x4*)(vp_ + 4); \
            const f32x4 o0 = (d0 * rstd * lw0 + lb0 + v0 * bon) * bf_lo4(gq, 0), o1 = (d1 * rstd * lw1 + lb1 + v1 * bon) * bf_lo4(gq, 1); \
            if (ST_) *(u32x4*)((unsigned short*)YG + idx) = pack8(o0, o1); } while (0)
        if (rec) {
            __syncthreads();
            int sbuf = 0;
            for (int c = 0; c < NCH; ++c) {
                const int cb = c & 1, sb = sbuf; sbuf = sbuf == 2 ? 0 : sbuf + 1;
                const LAS float* st = stage + sb * CHF + 8 * kq; const LAS float* sv = stage + sb * CHF + 320 + row; LAS float* yb = ybuf + cb * TC * 64 + row;
                f32x4 na[2], wd[2], bb[2], kp[2], rr[2];
#pragma unroll
                for (int q = 0; q < 2; ++q) { na[q] = *(const LAS f32x4*)(st + 4 * q); wd[q] = *(const LAS f32x4*)(st + 64 + 4 * q); bb[q] = *(const LAS f32x4*)(st + 128 + 4 * q); kp[q] = *(const LAS f32x4*)(st + 192 + 4 * q); rr[q] = *(const LAS f32x4*)(st + 256 + 4 * q); }
                f32x2v vv = *(const LAS f32x2v*)(sv);
#define RW_PR(v_, i_) ((f32x2v){v_[(i_) >> 1][2 * ((i_) & 1)], v_[(i_) >> 1][2 * ((i_) & 1) + 1]})
                float yq0 = 0.f, yq1 = 0.f;
#pragma unroll
                for (int tl = 0; tl < TC; ++tl) {
                    f32x4 na2[2], wd2[2], bb2[2], kp2[2], rr2[2]; f32x2v vv2 = vv;
#pragma unroll
                    for (int q = 0; q < 2; ++q) { na2[q] = na[q]; wd2[q] = wd[q]; bb2[q] = bb[q]; kp2[q] = kp[q]; rr2[q] = rr[q]; }
                    if (tl + 1 < TC) { const LAS float* sp = st + (tl + 1) * STEPF;
#pragma unroll
                        for (int q = 0; q < 2; ++q) { na2[q] = *(const LAS f32x4*)(sp + 4 * q); wd2[q] = *(const LAS f32x4*)(sp + 64 + 4 * q); bb2[q] = *(const LAS f32x4*)(sp + 128 + 4 * q); kp2[q] = *(const LAS f32x4*)(sp + 192 + 4 * q); rr2[q] = *(const LAS f32x4*)(sp + 256 + 4 * q); }
                        vv2 = *(const LAS f32x2v*)(sv + (tl + 1) * STEPF); }
                    __builtin_amdgcn_sched_barrier(0);
                    f32x2v p0 = S0[0] * RW_PR(na, 0), p1 = S1[0] * RW_PR(na, 0);
#pragma unroll
                    for (int i = 1; i < 4; ++i) { p0 = S0[i] * RW_PR(na, i) + p0; p1 = S1[i] * RW_PR(na, i) + p1; }
                    float sa0 = p0[0] + p0[1], sa1 = p1[0] + p1[1];
                    sa0 += WS_DPP(sa0, 0xB1); sa1 += WS_DPP(sa1, 0xB1); yq0 += WS_DPP(yq0, 0xB1); yq1 += WS_DPP(yq1, 0xB1);
                    sa0 += WS_DPP(sa0, 0x4E); sa1 += WS_DPP(sa1, 0x4E); yq0 += WS_DPP(yq0, 0x4E); yq1 += WS_DPP(yq1, 0x4E);
                    sa0 += WS_DPP(sa0, 0x141); sa1 += WS_DPP(sa1, 0x141); yq0 += WS_DPP(yq0, 0x141); yq1 += WS_DPP(yq1, 0x141);
                    asm("" : "+v"(yq0), "+v"(yq1));
                    if (tl > 0) *(LAS f32x2v*)(yb + (tl - 1) * 64) = (f32x2v){yq0, yq1};
                    const f32x2v s0 = {sa0, sa0}, s1 = {sa1, sa1}, v0 = {vv[0], vv[0]}, v1 = {vv[1], vv[1]};
#pragma unroll
                    for (int i = 0; i < 4; ++i) { S0[i] = S0[i] * RW_PR(wd, i) + (RW_PR(bb, i) * s0 + RW_PR(kp, i) * v0); S1[i] = S1[i] * RW_PR(wd, i) + (RW_PR(bb, i) * s1 + RW_PR(kp, i) * v1); }
                    f32x2v q0 = S0[0] * RW_PR(rr, 0), q1 = S1[0] * RW_PR(rr, 0);
#pragma unroll
                    for (int i = 1; i < 4; ++i) { q0 = S0[i] * RW_PR(rr, i) + q0; q1 = S1[i] * RW_PR(rr, i) + q1; }
                    yq0 = q0[0] + q0[1]; yq1 = q1[0] + q1[1];
#pragma unroll
                    for (int q = 0; q < 2; ++q) { na[q] = na2[q]; wd[q] = wd2[q]; bb[q] = bb2[q]; kp[q] = kp2[q]; rr[q] = rr2[q]; }
                    vv = vv2;
                }
                yq0 += WS_DPP(yq0, 0xB1); yq1 += WS_DPP(yq1, 0xB1); yq0 += WS_DPP(yq0, 0x4E); yq1 += WS_DPP(yq1, 0x4E); yq0 += WS_DPP(yq0, 0x141); yq1 += WS_DPP(yq1, 0x141);
                asm("" : "+v"(yq0), "+v"(yq1));
                *(LAS f32x2v*)(yb + (TC - 1) * 64) = (f32x2v){yq0, yq1};
#undef RW_PR
                __syncthreads();
            }
            __syncthreads();
        } else if (bgw) {
            f32x4 va[16]; f32x2v ga[8];
#define BG_T(N_) ((bg_gw + (N_) * bg_ngw) < BG_TOTAL ? (bg_gw + (N_) * bg_ngw) : BG_TOTAL - 1)
            int tA = BG_T(bg_n);
            { const BgTile d = bg_decode(tA, ws); bg_issue(d, va, ga, lane); }
            __syncthreads();
            for (int c = 0; c < NCH; ++c) {
                { const BgTile d = bg_decode(tA, ws); bg_finish(d, d.dst(d.n0) + d.k0, d.dst.ld, va, ga, bgs, lane); }
                tA = BG_T(bg_n + c + 1); { const BgTile d = bg_decode(tA, ws); bg_issue(d, va, ga, lane); }
                __syncthreads();
            }
            { const BgTile d = bg_decode(tA, ws); bg_finish(d, d.dst(d.n0) + d.k0, d.dst.ld, va, ga, bgs, lane); }
            bg_n += NCH + 1;
#undef BG_T
            __syncthreads();
        } else {
            RW_LOAD(0); RW_PUT(0); RW_LOAD(1); RW_GLOAD(0);
            __syncthreads();
            int sbuf = 0;
            for (int c = 0; c < NCH; ++c) {
                const int sn = sbuf == 2 ? 0 : sbuf + 1; sbuf = sn;
                RW_POST(c > 0 ? c - 1 : 0, c > 0);
                RW_PUT(sn);
                RW_LOAD(c + 2 < NCH ? c + 2 : NCH - 1);
                RW_GLOAD(c);
                __syncthreads();
            }
            RW_POST(NCH - 1, true);
            __syncthreads();
        }
#undef RW_LOAD
#undef RW_PUT
#undef RW_POST
#undef RW_GLOAD
    }
    __builtin_amdgcn_s_setprio(0);
    if (bgw) { f32x4 bgv[16]; f32x2v bgg[8];
        for (int t = bg_gw + bg_n * bg_ngw; t < BG_TOTAL; t += bg_ngw) { const BgTile d = bg_decode(t, ws); bg_issue(d, bgv, bgg, lane); bg_finish(d, nullptr, 0, bgv, bgg, bgs, lane); }
    }
}

#ifndef MK_SPLIT
#define MK_SPLIT 0
#endif
constexpr int N_PHASES = 1 + 8 * 2 + 2 * 6 + 7 + 6 + 1;
struct Args { const void* in[51]; float* out; unsigned char* ws; int ph_lo, ph_hi; };
static_assert(sizeof(Args) == 51 * 8 + 8 + 8 + 8, "Args has no padding");

template <unsigned PMASK> __global__ void __launch_bounds__(NTHR, 2) mega_fwd(Args args) {
    extern __shared__ __attribute__((aligned(16))) unsigned char lds[];
    LAS unsigned char* ldsl = (LAS unsigned char*)lds;
    const int G = gridDim.x, bx = blockIdx.x, vcu = (G % 8 == 0) ? (bx % 8) * (G / 8) + bx / 8 : bx;
    const int ngw = G * NWAVES, gthreads = G * NTHR, wave_s = __builtin_amdgcn_readfirstlane(threadIdx.x >> 6);
    for (int u = threadIdx.x; u < (LDS_BYTES - LDSCTL_OFF) / 4; u += NTHR) ((LAS unsigned*)(ldsl + LDSCTL_OFF))[u] = 0u;
    __syncthreads();
    XcdBarrier bar; bar.bar = (unsigned*)(args.ws + WS_CTL) + CW_BAR; bar.x = 0; bar.st = nullptr;
    if (!MK_SPLIT) bar = xcd_barrier_post((unsigned*)(args.ws + WS_CTL) + CW_BAR, (volatile LAS unsigned*)(ldsl + LDSCTL_OFF) + 8);
    const int lo = args.ph_lo, hi = args.ph_hi; int ph = 0;
    int ni = 0;
#ifndef DUP_MASK
#define DUP_MASK 0u
#endif
#define PB(b) if constexpr (((PMASK) >> (b)) & 1u) for (int rep_ = 0; rep_ < ((((DUP_MASK) >> (b)) & 1u) ? 2 : 1); ++rep_, (rep_ < 2 && (((DUP_MASK) >> (b)) & 1u)) ? __syncthreads() : (void)0)
#define PH_ON() (ph >= lo && ph < hi)
#define PH_END() do { if (!MK_SPLIT && ph >= lo && ph + 1 < hi) { XcdBarrier b_ = bar; asm volatile("" : "+s"(b_.bar), "+s"(b_.x)); xcd_barrier(b_); } ++ph; } while (0)
#define PH_VARS const int tid = opaque_tid_w(wave_s), lane = tid & 63, wave = wave_s, gw = vcu * NWAVES + wave, gtid = vcu * NTHR + tid; \
    int zo; asm volatile("s_mov_b32 %0, 0" : "=s"(zo)); unsigned char* const ws = args.ws + zo; unsigned char* const scr = ws + WS_SCR; \
    bf16* const XH = (bf16*)(ws + WS_XH); bf16* const XL = (bf16*)(ws + WS_XL); unsigned long long* const rsqc = (unsigned long long*)(ws + CTL_RSQ) + (size_t)ni * MT; bf16* const OB = (bf16*)(ws + WS_OB); const f32x2v* const T64 = (const f32x2v*)(ws + WS_T64); const f32x2v* const T128 = (const f32x2v*)(ws + WS_T128); \
    (void)lane; (void)gw; (void)gtid; (void)scr; (void)XH; (void)XL; (void)rsqc; (void)OB; (void)T64; (void)T128;
#define INF(k) ((const float*)args.in[(k) + zo])
#define PH_END_NOBAR() do { ++ph; } while (0)
#define RUN_GEMM(EPI_T, EPI_OBJ, A_, B_, N_, K_) do { pg8::Gemm g_{(const pg8::bf16_t*)(A_), (const pg8::bf16_t*)(B_), MT, (N_), (K_)}; pg8::StaticOrder S_; S_.init(MT, (N_), G, bx); \
        pg8::gemm_phase<EPI_T, pg8::StaticOrder, true, true>(ldsl, g_, S_, (EPI_OBJ), wave_s); } while (0)

#define CVT_BEGIN LAS float* cs = (LAS float*)(ldsl + wave * CVT_WAVE_BYTES); int rot = 0;
#define CVT(W_, G_, KS_, KD_, N_, MODE_, BASE_, BASE2_, LD_) rot = cvt_matrix_any((W_), (G_), (KS_), (KD_), (N_), (MODE_), (bf16*)(BASE_), (bf16*)(BASE2_), (LD_), gw, ngw, rot, cs, lane)
#define CVT_FFN(I_) do { const int L_ = (I_) >> 1, j_ = (I_) & 1, fb_ = L_ == 0 ? 2 : (L_ == 1 ? 12 : (L_ == 2 ? 18 : 40)); unsigned char* wf = ws + WS_WFFN + (size_t)(I_) * SZ_FFN; \
        CVT(INF(fb_ + 1) + (size_t)j_ * DM * 2 * DFF, INF(fb_) + j_ * DM, DM, DM, 2 * DFF, 1, wf, nullptr, DM); \
        CVT(INF(fb_ + 2) + (size_t)j_ * DFF * DM, nullptr, DFF, DFF, DM, 0, wf + SZ_WGU, nullptr, DFF); } while (0)
#define CVT_MLA(M_) do { const int mb = (M_) ? 44 : 6; unsigned char* wb = ws + WS_WMLA + (size_t)(M_) * SZ_MLA; \
        CVT(INF(mb + 0), INF(mb - 1), DM, DM, 1600, 0, wb, nullptr, DM); \
        zero_bytes(wb + (size_t)1600 * DM * 2, 192u * DM * 2, gtid, gthreads); \
        CVT(INF(mb + 2), INF(mb + 1), 1024, 1024, 6144, 2, wb + SZ_MLA_IN, nullptr, 1024); \
        CVT(INF(mb + 4), INF(mb + 3), 512, 512, 8192, 0, wb + SZ_MLA_IN + SZ_MLA_UQ, nullptr, 512); \
        CVT(INF(mb + 5), nullptr, DM, DM, DM, 0, wb + SZ_MLA_IN + SZ_MLA_UQ + SZ_MLA_UKV, nullptr, DM); } while (0)
#define CVT_DSA_SMALL() do { unsigned char* wb = ws + WS_WDSA; \
        for (int ks_ = 0; ks_ < 8; ++ks_) zero_bytes(wb + SZ_DSA_IN + ((size_t)ks_ * 256 + 160) * 512 * 2, 96u * 512 * 2, gtid, gthreads); } while (0)
#define CVT_RWKV_SMALL() do { unsigned char* wb = ws + WS_WRW; \
        CVT(INF(28), nullptr, DM, DM, 128, 0, wb + RW_W1, nullptr, DM); zero_bytes(wb + RW_W1 + (size_t)128 * DM * 2, 128u * DM * 2, gtid, gthreads); \
        CVT(INF(31), nullptr, DM, DM, 128, 0, wb + RW_A1, nullptr, DM); zero_bytes(wb + RW_A1 + (size_t)128 * DM * 2, 128u * DM * 2, gtid, gthreads); \
        CVT(INF(33), nullptr, DM, DM, 480, 0, wb + RW_G1, nullptr, DM); zero_bytes(wb + RW_G1 + (size_t)480 * DM * 2, 32u * DM * 2, gtid, gthreads); \
        CVT(INF(29), nullptr, 128, 256, DM, 0, wb + RW_W2, nullptr, 256); \
        CVT(INF(32), nullptr, 128, 256, DM, 0, wb + RW_A2, nullptr, 256); \
        CVT(INF(34), nullptr, 480, 512, DM, 0, wb + RW_G2, nullptr, 512); } while (0)
    if (PH_ON()) PB(0) { PH_VARS CVT_BEGIN
        rope_tables((const int*)args.in[1 + zo], (f32x2v*)(ws + WS_T64), (f32x2v*)(ws + WS_T128), gtid, gthreads);
        phase_split_x(INF(0), XH, XL, rsqc, gw, ngw, lane);
        cvt_list_pipelined<true>(0, ws, gw, ngw, (LAS unsigned*)(ldsl + wave * CVT_WAVE_BYTES), lane);
    }
    PH_END();

    for (int i = 0; i < 8; ++i) {
        const int L = i >> 1, j = i & 1, fb = L == 0 ? 2 : (L == 1 ? 12 : (L == 2 ? 18 : 40));
        if (PH_ON()) PB(2) { PH_VARS EpiSwiglu E{(pg8::bf16_t*)(scr + SC_ACT), rsqc}; RUN_GEMM(EpiSwiglu, E, XH, ws + WS_WFFN + (size_t)i * SZ_FFN, 2 * DFF, DM); }
        PH_END();
        if (PH_ON()) PB(3) { PH_VARS EpiResid E{(pg8::bf16_t*)XH, (pg8::bf16_t*)XL, rsqc + MT, rep_ ? 0.0f : 0.5f}; RUN_GEMM(EpiResid, E, scr + SC_ACT, ws + WS_WFFN + (size_t)i * SZ_FFN + SZ_WGU, DM, DFF);
            CVT_BEGIN
            if (j == 0) { if (L < 3) cvt_list_pipelined<false>(L, ws, gw, ngw, (LAS unsigned*)cs, lane); }
            else if (i + 1 < 8 && i != 5) cvt_list_pipelined<true>(i + 1, ws, gw, ngw, (LAS unsigned*)cs, lane);
            if (j == 0) { if (L == 1) CVT_DSA_SMALL(); else if (L == 2) CVT_RWKV_SMALL(); else zero_bytes(ws + WS_WMLA + (size_t)(L ? 1 : 0) * SZ_MLA + (size_t)1600 * DM * 2, 192u * DM * 2, gtid, gthreads); } }
        PH_END(); ++ni;
        if (j == 1) continue;
        size_t wo_off;
        if (L == 0 || L == 3) {
            const int mb = L ? 44 : 6; const size_t wbo = WS_WMLA + (size_t)(L ? 1 : 0) * SZ_MLA; wo_off = wbo + SZ_MLA_IN + SZ_MLA_UQ + SZ_MLA_UKV;
            if (PH_ON()) PB(4) { PH_VARS unsigned long long* const rsqm = (unsigned long long*)(ws + CTL_RSQ) + (size_t)(N_RSQ + (rep_ ? 4 : (L ? 2 : 0))) * MT;
                EpiMlaIn E{(pg8::bf16_t*)(scr + ML_CQN), (pg8::bf16_t*)(scr + ML_LAT), T64, rsqc, rsqm};
                RUN_GEMM(EpiMlaIn, E, XH, ws + wbo, 1792, DM); }
            PH_END();
            if (PH_ON()) PB(6) { PH_VARS unsigned long long* const rsqm = (unsigned long long*)(ws + CTL_RSQ) + (size_t)(N_RSQ + (L ? 2 : 0)) * MT; EpiMlaQ E1{(pg8::bf16_t*)(scr + ML_Q), T64, rsqm}; RUN_GEMM(EpiMlaQ, E1, scr + ML_CQN, ws + wbo + SZ_MLA_IN, 6144, 1024); }
            PH_END_NOBAR();
            if (PH_ON()) PB(20) { PH_VARS unsigned long long* const rsqm = (unsigned long long*)(ws + CTL_RSQ) + (size_t)(N_RSQ + (L ? 2 : 0)) * MT; EpiMlaKV E2{(pg8::bf16_t*)(scr + ML_K), (pg8::bf16_t*)(scr + ML_V), rsqm + MT, (const pg8::bf16_t*)(scr + ML_LAT)}; RUN_GEMM(EpiMlaKV, E2, scr + ML_CKV, ws + wbo + SZ_MLA_IN + SZ_MLA_UQ, 8192, 512); }
            PH_END();
            if (PH_ON()) PB(7) { PH_VARS const float scale = 0.07216878364870322f;
                const bf16* Q = (const bf16*)(scr + ML_Q); const bf16* KF = (const bf16*)(scr + ML_K); const bf16* VB = (const bf16*)(scr + ML_V);
                for (int it = vcu; it < 1024; it += G) { int bh, qb; att::unit_of(it, bh, qb); const int b = bh >> 5, h = bh & 31; const size_t tok0 = (size_t)b * SEQ + 256 * qb, tokb = (size_t)b * SEQ;
                    att::attn_unit<192, 6144, 6144, 4096, false>(Q + tok0 * 6144 + h * 192, KF + tokb * 6144 + h * 192, VB + tokb * 4096 + h * 128, OB + tok0 * 4096 + h * 128,
                                                                 nullptr, qb, scale * 1.4426950408889634f, 8.0f / scale, (char*)lds, wave_s); } }
            PH_END();
        } else if (L == 1) {
            wo_off = WS_WDSA + SZ_DSA_IN + SZ_DSA_NAR;
            if (PH_ON()) PB(8) { PH_VARS EpiDsaIn E1{(pg8::bf16_t*)(scr + DS_Q), (pg8::bf16_t*)(scr + DS_K), (pg8::bf16_t*)(scr + DS_V), (pg8::bf16_t*)(scr + DS_QI), T64, T128, rsqc}; RUN_GEMM(EpiDsaIn, E1, XH, ws + WS_WDSA, 10240, DM); }
            PH_END_NOBAR();
            if (PH_ON()) PB(21) { PH_VARS EpiF32 E2{(float*)(scr + DS_KIW), 2048, rsqc};
                pg8::Gemm g_{(const pg8::bf16_t*)XH, (const pg8::bf16_t*)(ws + WS_WDSA + SZ_DSA_IN), MT, 2048, 512}; SplitKOrder S_; S_.G = G; S_.c = bx;
                pg8::gemm_phase<EpiF32, SplitKOrder, true, true>(ldsl, g_, S_, E2, wave_s); }
            PH_END();
            if (PH_ON()) PB(9) { PH_VARS phase_dsa_kiw((const float*)(scr + DS_KIW), T64, (bf16*)(scr + DS_KI), (float*)(scr + DS_WI), gw, ngw, lane); }
            PH_END();
            if (PH_ON()) PB(10) { PH_VARS phase_dsa_indexer((const bf16*)(scr + DS_QI), (const bf16*)(scr + DS_KI), (const float*)(scr + DS_WI), (float*)(scr + DS_SC), (LAS float*)ldsl, vcu, G, wave_s); }
            PH_END();
            if (PH_ON()) PB(11) { PH_VARS phase_dsa_topk((const float*)(scr + DS_SC), (unsigned*)(scr + DS_MASK), gw, ngw, lane); }
            PH_END();
            if (PH_ON()) PB(12) { PH_VARS const float scale = 0.08838834764831845f;
                const bf16* QD = (const bf16*)(scr + DS_Q); const bf16* KD = (const bf16*)(scr + DS_K); const bf16* VD = (const bf16*)(scr + DS_V); const unsigned* MASK = (const unsigned*)(scr + DS_MASK);
                for (int it = vcu; it < 1024; it += G) { int bh, qb; att::unit_of(it, bh, qb); const int b = bh >> 5, h = bh & 31; const size_t tok0 = (size_t)b * SEQ + 256 * qb, tokb = (size_t)b * SEQ;
                    att::attn_unit<128, 4096, 1024, 1024, true>(QD + tok0 * 4096 + h * 128, KD + tokb * 1024 + (h >> 2) * 128, VD + tokb * 1024 + (h >> 2) * 128, OB + tok0 * 4096 + h * 128,
                                                                MASK + tok0 * 64, qb, scale * 1.4426950408889634f, 8.0f / scale, (char*)lds, wave_s); } }
            PH_END();
        } else {
            wo_off = WS_WRW + RW_WO;
            constexpr size_t XS = (size_t)MT * DM;
            if (PH_ON()) PB(13) { PH_VARS phase_rwkv_mix(XH, XL, rsqc, INF(fb + 3), INF(22), (bf16*)(scr + RW_XR), gw, ngw, lane); }
            PH_END();
            if (PH_ON()) PB(14) { PH_VARS const bf16* XM = (const bf16*)(scr + RW_XR); const unsigned char* wb = ws + WS_WRW;
                static_assert(RW_K - RW_R == 128 * MiB && RW_V - RW_K == 128 * MiB, "r | k | v are equally spaced");
                for (int s = 0; s < 3; ++s) { EpiF32 E{(float*)(scr + RW_R + (size_t)s * (128 * MiB)), DM, nullptr}; RUN_GEMM(EpiF32, E, XM + (size_t)(s + (s > 0)) * XS, wb + (size_t)s * SZ_SQ, DM, DM); }
            }
            PH_END_NOBAR();
            if (PH_ON()) PB(22) { PH_VARS const bf16* XM = (const bf16*)(scr + RW_XR); const unsigned char* wb = ws + WS_WRW;
                { static_assert(RW_LA - RW_TW == 4 * MiB && RW_SG - RW_LA == 4 * MiB, "TW | LA | SG spacing"); EpiRwNarrow E{(pg8::bf16_t*)(scr + RW_TW)};
                  pg8::Gemm g_{(const pg8::bf16_t*)XM, (const pg8::bf16_t*)(wb + RW_W1), MT, 1024, DM}; JobOrder S_; S_.init(MT, 1024, G, bx); S_.a_stride = XS * 2; S_.a_sel = 0x5541u;
                  pg8::gemm_phase<EpiRwNarrow, JobOrder, true, true>(ldsl, g_, S_, E, wave_s); }
            }
            PH_END();
            if (PH_ON()) PB(15) { PH_VARS const unsigned char* wb = ws + WS_WRW;
                for (int s = 0; s < 3; ++s) { EpiRw2 E{(float*)(scr + (s == 0 ? RW_DEC : (s == 1 ? RW_AA : RW_G))), INF(s == 0 ? 27 : 30), s};
                    RUN_GEMM(EpiRw2, E, scr + (s == 0 ? RW_TW : (s == 1 ? RW_LA : RW_SG)), wb + (s == 0 ? RW_W2 : (s == 1 ? RW_A2 : RW_G2)), DM, s == 2 ? 512 : 256); }
            }
            PH_END();
            if (PH_ON()) PB(17) { PH_VARS phase_rwkv_scan(scr, ws, INF(35), INF(36), INF(37), INF(38), INF(39), OB, (LAS float*)ldsl, vcu, G, wave_s); }
            PH_END();
        }
        if (PH_ON()) PB(18) { PH_VARS EpiResid E{(pg8::bf16_t*)XH, (pg8::bf16_t*)XL, rsqc + MT, rep_ ? 0.0f : 1.0f}; RUN_GEMM(EpiResid, E, OB, ws + wo_off, DM, DM);
            CVT_BEGIN if (L < 2) cvt_list_pipelined<true>(i + 1, ws, gw, ngw, (LAS unsigned*)cs, lane); (void)rot; }
        PH_END(); ++ni;
    }
    if (PH_ON()) PB(19) { PH_VARS phase_final_norm(XH, XL, rsqc, args.out + zo, INF(50), gw, ngw, lane); }
#undef CVT
#undef CVT_BEGIN
#undef CVT_FFN
#undef CVT_MLA
#undef CVT_DSA_SMALL
#undef CVT_RWKV_SMALL
#undef PH_ON
#undef PH_END
#undef RUN_GEMM
#undef PH_VARS
#undef INF
}

#ifndef PHASE_MASK
#define PHASE_MASK 0xFFFFFFFFu
#endif
constexpr unsigned THIN_BITS = (1u << 0) | (1u << 1) | (1u << 5) | (1u << 9) | (1u << 10) | (1u << 11) | (1u << 13) | (1u << 16) | (1u << 17) | (1u << 19);
#if MK_SPLIT
static int phase_bits(int* out) {
    int n = 0; out[n++] = 0;
    for (int i = 0; i < 8; ++i) { const int L = i >> 1, j = i & 1;
        out[n++] = 2; out[n++] = 3;
        if (j == 1) continue;
        if (L == 0 || L == 3) { const int b[] = {4, 5, 6, 20, 7}; for (int k = 0; k < 5; ++k) out[n++] = b[k]; }
        else if (L == 1) { const int b[] = {8, 21, 9, 10, 11, 12}; for (int k = 0; k < 6; ++k) out[n++] = b[k]; }
        else { const int b[] = {13, 14, 22, 15, 17}; for (int k = 0; k < 5; ++k) out[n++] = b[k]; }
        out[n++] = 18; }
    out[n++] = 19; return n;
}
#endif
#if MK_SPLIT
typedef void (*kern_t)(Args);
static kern_t kernel_for_bit(int bit) {
    if ((THIN_BITS >> bit) & 1u) return mega_fwd<THIN_BITS>;
    switch (bit) {
        case 2: return mega_fwd<1u << 2>; case 3: return mega_fwd<1u << 3>; case 4: return mega_fwd<1u << 4>; case 6: return mega_fwd<1u << 6>; case 20: return mega_fwd<1u << 20>;
        case 7: return mega_fwd<1u << 7>; case 8: return mega_fwd<1u << 8>; case 21: return mega_fwd<1u << 21>; case 12: return mega_fwd<1u << 12>; case 14: return mega_fwd<1u << 14>;
        case 15: return mega_fwd<1u << 15>; case 18: return mega_fwd<1u << 18>; case 22: return mega_fwd<1u << 22>; default: return nullptr; }
}
#endif
extern "C" void kernel_launch(void* const* d_in, const int* in_sizes, int n_in, void* d_out, int out_size, void* d_ws, size_t ws_size, hipStream_t stream) {
    static int grid = 0;
    if (grid == 0) {
        if (n_in != 51 || in_sizes[0] != MT * DM || out_size != MT * DM || ws_size < WS_END) {
            fprintf(stderr, "kernel_launch: unexpected shapes: n_in %d in0 %d out %d ws %zu (need %zu); nothing launched\n", n_in, n_in > 0 ? in_sizes[0] : -1, out_size, ws_size, (size_t)WS_END); grid = -1; return; }
        int dev = 0, cus = 0;
        if (hipGetDevice(&dev) != hipSuccess || hipDeviceGetAttribute(&cus, hipDeviceAttributeMultiprocessorCount, dev) != hipSuccess) { grid = -1; return; }
#if MK_SPLIT
        for (int bit = 0; bit < 23; ++bit) { kern_t k = kernel_for_bit(bit); if (k && hipFuncSetAttribute((const void*)k, hipFuncAttributeMaxDynamicSharedMemorySize, LDS_BYTES) != hipSuccess) { fprintf(stderr, "kernel_launch: hipFuncSetAttribute failed (bit %d)\n", bit); grid = -1; return; } }
#else
        if (hipFuncSetAttribute((const void*)mega_fwd<PHASE_MASK>, hipFuncAttributeMaxDynamicSharedMemorySize, LDS_BYTES) != hipSuccess) { fprintf(stderr, "kernel_launch: hipFuncSetAttribute failed\n"); grid = -1; return; }
#endif
        (void)hipGetLastError();
        grid = cus;
    }
    if (grid < 0) return;
    (void)hipMemsetAsync((char*)d_ws + WS_CTL, 0, CTL_BYTES, stream);
    Args a{};
    for (int i = 0; i < 51; ++i) a.in[i] = d_in[i];
    a.out = (float*)d_out; a.ws = (unsigned char*)d_ws;
#if MK_SPLIT
    int bits[80]; const int np = phase_bits(bits);
    for (int p = 0; p < np; ++p) { a.ph_lo = p; a.ph_hi = p + 1; kern_t k = kernel_for_bit(bits[p]); hipLaunchKernelGGL(k, dim3(grid), dim3(NTHR), LDS_BYTES, stream, a); }
#else
    a.ph_lo = 0; a.ph_hi = 1 << 30;
    hipLaunchKernelGGL(mega_fwd<PHASE_MASK>, dim3(grid), dim3(NTHR), LDS_BYTES, stream, a);
#endif
    const hipError_t le = hipPeekAtLastError();
    if (le != hipSuccess) fprintf(stderr, "kernel_launch: launch failed: %s\n", hipGetErrorName(le));
}
```

```cpp
#include <hip/hip_runtime.h>
#include <cstdio>
#include <cstdint>
__device__ __forceinline__ int opaque_tid_w(int wave_sgpr) { int t = (int)__builtin_amdgcn_mbcnt_hi(~0u, __builtin_amdgcn_mbcnt_lo(~0u, 0u)); asm volatile("" : "+v"(t)); return wave_sgpr * 64 + t; }
namespace pg8 {
#define PG8_LAS __attribute__((address_space(3)))
typedef unsigned short bf16_t;
typedef short bf16x8 __attribute__((ext_vector_type(8)));
typedef float f32x4 __attribute__((ext_vector_type(4)));
typedef unsigned u32x4 __attribute__((ext_vector_type(4)));
constexpr int BM = 256, BK = 64, HALF = 128, HTB = HALF * BK * 2  , STAGE_BYTES = 8 * HTB, NXCD = 8, WGM = 8;

__host__ __device__ __forceinline__ int lds_byte(int r, int c) { const int st = (r >> 4) * 2 + (c >> 5), rr = r & 15, cc = c & 31, ob = rr * 64 + cc * 2; return st * 1024 + (ob ^ (((ob >> 9) & 1) << 5)); }
__host__ __device__ __forceinline__ void stage_rc(int b, int& R, int& C) { const int st = b / 1024, sb = b % 1024, swz = sb ^ (((sb >> 9) & 1) << 5); R = (st >> 1) * 16 + swz / 64; C = (st & 1) * 32 + (swz % 64) / 2; }
__host__ __device__ __forceinline__ int perm32(int rho) { const int n = rho >> 4, i = rho & 15; return 8 * (i >> 2) + 4 * n + (i & 3); }

struct Unit { int pm, pn; };
struct Gemm { const bf16_t* A; const bf16_t* Bt; int M, N, K; };

struct StaticOrder {
    static constexpr int LDA = 0;
    int nM, nN, nwg, G, c;
    __host__ __device__ void init(int M, int N, int G_, int c_) { nM = M / BM; nN = N / BM; nwg = nM * nN; G = G_; c = c_; }
    __host__ __device__ bool next(int i, Unit& u) const {
        const long L = (long)i * G + c; if (L >= nwg) return false;
        int wgid = (int)L; { const int q = nwg / NXCD, r = nwg % NXCD, xcd = wgid % NXCD, off = wgid / NXCD; wgid = (xcd < r ? xcd * (q + 1) : r * (q + 1) + (xcd - r) * q) + off; }
        const int nig = WGM * nN, gid = wgid / nig, fm = gid * WGM, gsz = (nM - fm) < WGM ? (nM - fm) : WGM;
        u.pm = fm + ((wgid % nig) % gsz); u.pn = (wgid % nig) / gsz; return true;
    }
    __device__ __forceinline__ size_t a_off(const Unit&) const { return 0; }
    __device__ __forceinline__ void a_ready(const Unit&) const {}
    __device__ __forceinline__ void done(const Unit&) const {}
};
__device__ __forceinline__ unsigned cvt_pk_bf16(float lo, float hi) { unsigned r; asm volatile("v_cvt_pk_bf16_f32 %0, %1, %2" : "=v"(r) : "v"(lo), "v"(hi)); return r; }
typedef float f32x2 __attribute__((ext_vector_type(2)));
template <class Epi, class Sched, bool ALIGN_EPI = false, bool SP2 = false>
__device__ __forceinline__ void gemm_phase(PG8_LAS unsigned char* lds, const Gemm g, const Sched& S, const Epi& E, int wave_s) {
    const int tid = opaque_tid_w(wave_s), wid = wave_s, lane = tid & 63, wr = wid >> 2, wc = wid & 3, fr = lane & 15, fq = lane >> 4;
    const int K = g.K, nt = K / BK, LDA = Sched::LDA ? Sched::LDA : K;
    unsigned voffA[2], voffB[2];
#pragma unroll
    for (int i = 0; i < 2; ++i) { int R, C; stage_rc(tid * 16 + i * 8192, R, C); const int Rb = Epi::PERM ? ((R & ~31) + perm32(R & 31)) : R;
        voffA[i] = (unsigned)(R * LDA + C) * 2u; voffB[i] = (unsigned)(Rb * K + C) * 2u; }
    const size_t kstep = (size_t)(BK * 2);
    const size_t hstep = (size_t)HALF * K * 2;
    const size_t tstep = 2 * hstep;
    const size_t hstepA = (size_t)HALF * LDA * 2, tstepA = 2 * hstepA;
    const unsigned ldsw = (unsigned)wid * 1024u;
    const int aoff = lds_byte(wr * 64 + fr, fq * 8), boff = lds_byte(wc * 32 + fr, fq * 8);
#define PG8_SA(b, h) (((b) * 2 + (h)) * HTB)
#define PG8_SB(b, h) ((4 + (b) * 2 + (h)) * HTB)
#define PG8_STAGE(bufoff, gbase, voff) do { _Pragma("unroll") for (int _i = 0; _i < 2; ++_i) \
        __builtin_amdgcn_global_load_lds((const unsigned*)((const char*)(gbase) + (voff)[_i]), (PG8_LAS unsigned*)(lds + (bufoff) + ldsw + _i * 8192), 16, 0, 0); } while (0)
#define PG8_LDA(dst, b, h) do { _Pragma("unroll") for (int m = 0; m < 4; ++m) _Pragma("unroll") for (int k = 0; k < 2; ++k) dst[m][k] = *(const PG8_LAS bf16x8*)(lds + PG8_SA(b, h) + aoff + m * 2048 + k * 1024); } while (0)
#define PG8_LDB(dst, b, h) do { _Pragma("unroll") for (int n = 0; n < 2; ++n) _Pragma("unroll") for (int k = 0; k < 2; ++k) dst[n][k] = *(const PG8_LAS bf16x8*)(lds + PG8_SB(b, h) + boff + n * 2048 + k * 1024); } while (0)
#define PG8_MMA(ai, bj, At, Bt) do { __builtin_amdgcn_s_setprio(1); _Pragma("unroll") for (int m = 0; m < 4; ++m) _Pragma("unroll") for (int n = 0; n < 2; ++n) _Pragma("unroll") for (int k = 0; k < 2; ++k) \
        acc[ai][bj][m][n] = __builtin_amdgcn_mfma_f32_16x16x32_bf16(Bt[n][k], At[m][k], acc[ai][bj][m][n], 0, 0, 0); __builtin_amdgcn_s_setprio(0); } while (0)
#define PG8_WAIT_V(n) asm volatile("s_waitcnt vmcnt(" #n ")" ::: "memory")
#define PG8_WAIT_L(n) asm volatile("s_waitcnt lgkmcnt(" #n ")" ::: "memory")
#define PG8_BAR __builtin_amdgcn_s_barrier()
#define PG8_SCHED __builtin_amdgcn_sched_barrier(0)
    Unit cur, nxt; int ui = 0;
    if (!S.next(0, cur)) return;
    f32x4 acc[2][2][4][2];
#pragma unroll
    for (int a = 0; a < 2; ++a)
#pragma unroll
        for (int b = 0; b < 2; ++b)
#pragma unroll
            for (int m = 0; m < 4; ++m)
#pragma unroll
                for (int n = 0; n < 2; ++n) acc[a][b][m][n] = (f32x4){0.f, 0.f, 0.f, 0.f};
    bf16x8 At[4][2], B0[2][2], B1[2][2];
    const char* cA = (const char*)g.A + (size_t)cur.pm * tstepA + S.a_off(cur); const char* cB = (const char*)g.Bt + (size_t)cur.pn * tstep;
    S.a_ready(cur);
    if constexpr (SP2) {
        PG8_STAGE(PG8_SB(0, 0), cB, voffB); PG8_STAGE(PG8_SB(0, 1), cB + hstep, voffB); PG8_STAGE(PG8_SA(0, 0), cA, voffA); PG8_STAGE(PG8_SA(0, 1), cA + hstepA, voffA);
        if (wr == 1) PG8_BAR;
        PG8_WAIT_V(2); PG8_BAR;
        PG8_STAGE(PG8_SB(1, 0), cB + kstep, voffB); PG8_STAGE(PG8_SA(1, 0), cA + kstep, voffA); PG8_STAGE(PG8_SB(1, 1), cB + hstep + kstep, voffB);
        PG8_WAIT_V(6); PG8_BAR;
    } else {
        PG8_STAGE(PG8_SB(0, 0), cB, voffB); PG8_STAGE(PG8_SA(0, 0), cA, voffA); PG8_STAGE(PG8_SB(0, 1), cB + hstep, voffB); PG8_STAGE(PG8_SA(0, 1), cA + hstepA, voffA);
        if (wr == 1) PG8_BAR;
        PG8_WAIT_V(4); PG8_BAR;
        PG8_STAGE(PG8_SB(1, 0), cB + kstep, voffB); PG8_STAGE(PG8_SA(1, 0), cA + kstep, voffA); PG8_STAGE(PG8_SB(1, 1), cB + hstep + kstep, voffB);
        PG8_WAIT_V(6); PG8_BAR;
    }
    for (;;) {
        const bool has_next = S.next(ui + 1, nxt);
        const char* nA = has_next ? (const char*)g.A + (size_t)nxt.pm * tstepA + S.a_off(nxt) : cA; const char* nB = has_next ? (const char*)g.Bt + (size_t)nxt.pn * tstep : cB;
        for (int t = 0; t < nt; t += 2) {
            const bool last = (t == nt - 2);
            const char* a1 = cA + (size_t)(t + 1) * kstep;
            const char* a2 = last ? nA : cA + (size_t)(t + 2) * kstep; const char* b2 = last ? nB : cB + (size_t)(t + 2) * kstep;
            const char* a3 = a2 + kstep; const char* b3 = b2 + kstep;
            if (last && has_next) S.a_ready(nxt);
            if constexpr (SP2) {
            PG8_LDB(B0, 0, 0); PG8_LDB(B1, 0, 1); PG8_SCHED; PG8_LDA(At, 0, 0); PG8_STAGE(PG8_SA(1, 1), a1 + hstepA, voffA);
            PG8_WAIT_V(8); PG8_WAIT_L(0); PG8_BAR; PG8_MMA(0, 0, At, B0); PG8_MMA(0, 1, At, B1); PG8_BAR; PG8_SCHED;
            PG8_LDA(At, 0, 1); PG8_STAGE(PG8_SB(0, 0), b2, voffB); PG8_STAGE(PG8_SB(0, 1), b2 + hstep, voffB); PG8_STAGE(PG8_SA(0, 0), a2, voffA);
            PG8_WAIT_V(8); PG8_WAIT_L(0); PG8_BAR; PG8_MMA(1, 0, At, B0); PG8_MMA(1, 1, At, B1); PG8_BAR; PG8_SCHED;
            PG8_LDB(B0, 1, 0); PG8_LDB(B1, 1, 1); PG8_SCHED; PG8_LDA(At, 1, 0); PG8_STAGE(PG8_SA(0, 1), a2 + hstepA, voffA);
            PG8_WAIT_V(8); PG8_WAIT_L(0); PG8_BAR; PG8_MMA(0, 0, At, B0); PG8_MMA(0, 1, At, B1); PG8_BAR; PG8_SCHED;
            PG8_LDA(At, 1, 1); PG8_STAGE(PG8_SB(1, 0), b3, voffB); PG8_STAGE(PG8_SB(1, 1), b3 + hstep, voffB); PG8_STAGE(PG8_SA(1, 0), a3, voffA);
            PG8_WAIT_V(8); PG8_WAIT_L(0); PG8_BAR; PG8_MMA(1, 0, At, B0); PG8_MMA(1, 1, At, B1); PG8_BAR; PG8_SCHED;
            } else {
            PG8_LDB(B0, 0, 0); PG8_SCHED; PG8_LDA(At, 0, 0); PG8_STAGE(PG8_SA(1, 1), a1 + hstepA, voffA);
            PG8_WAIT_L(8); PG8_BAR; PG8_WAIT_L(0); PG8_MMA(0, 0, At, B0); PG8_BAR; PG8_SCHED;
            PG8_LDB(B1, 0, 1); PG8_STAGE(PG8_SB(0, 0), b2, voffB);
            PG8_BAR; PG8_WAIT_L(0); PG8_MMA(0, 1, At, B1); PG8_BAR;
            PG8_LDA(At, 0, 1); PG8_STAGE(PG8_SA(0, 0), a2, voffA);
            PG8_BAR; PG8_WAIT_L(0); PG8_MMA(1, 0, At, B0); PG8_BAR; PG8_SCHED;
            PG8_STAGE(PG8_SB(0, 1), b2 + hstep, voffB);
            PG8_WAIT_V(6); PG8_BAR; PG8_MMA(1, 1, At, B1); PG8_BAR;
            PG8_LDB(B0, 1, 0); PG8_SCHED; PG8_LDA(At, 1, 0); PG8_STAGE(PG8_SA(0, 1), a2 + hstepA, voffA);
            PG8_WAIT_L(8); PG8_BAR; PG8_WAIT_L(0); PG8_MMA(0, 0, At, B0); PG8_BAR; PG8_SCHED;
            PG8_LDB(B1, 1, 1); PG8_STAGE(PG8_SB(1, 0), b3, voffB);
            PG8_BAR; PG8_WAIT_L(0); PG8_MMA(0, 1, At, B1); PG8_BAR;
            PG8_LDA(At, 1, 1); PG8_STAGE(PG8_SA(1, 0), a3, voffA);
            PG8_BAR; PG8_WAIT_L(0); PG8_MMA(1, 0, At, B0); PG8_BAR; PG8_SCHED;
            PG8_STAGE(PG8_SB(1, 1), b3 + hstep, voffB);
            PG8_WAIT_V(6); PG8_BAR; PG8_MMA(1, 1, At, B1); PG8_BAR;
            }
        }
        if constexpr (ALIGN_EPI) { if (wr == 0) PG8_BAR; }
        if constexpr (!Epi::AFTER_DRAIN) { E(acc, cur, wr, wc, fr, fq); S.done(cur); }
        if (!has_next) break;
#pragma unroll
        for (int a = 0; a < 2; ++a)
#pragma unroll
            for (int b = 0; b < 2; ++b)
#pragma unroll
                for (int m = 0; m < 4; ++m)
#pragma unroll
                    for (int n = 0; n < 2; ++n) acc[a][b][m][n] = (f32x4){0.f, 0.f, 0.f, 0.f};
        cur = nxt; cA = nA; cB = nB; ++ui;
        if constexpr (ALIGN_EPI) { if (wr == 1) PG8_BAR; }
    }
    PG8_WAIT_V(0);
    if constexpr (!ALIGN_EPI) { if (wr == 0) PG8_BAR; }
    PG8_BAR;
    if constexpr (Epi::AFTER_DRAIN) { E.fused(acc, cur, wr, wc, fr, fq, lds, wid, lane); S.done(cur); }
#undef PG8_SA
#undef PG8_SB
#undef PG8_STAGE
#undef PG8_LDA
#undef PG8_LDB
#undef PG8_MMA
#undef PG8_WAIT_V
#undef PG8_WAIT_L
#undef PG8_BAR
#undef PG8_SCHED
}
}

#define GAS __attribute__((address_space(1)))
#define LAS __attribute__((address_space(3)))
typedef unsigned short bf16;
typedef unsigned v4u __attribute__((ext_vector_type(4)));
typedef float f32x4 __attribute__((ext_vector_type(4)));
typedef short bf16x8 __attribute__((ext_vector_type(8)));
typedef GAS unsigned gu32;
typedef GAS unsigned long long gu64;
#define RLX_AGENT __ATOMIC_RELAXED, __HIP_MEMORY_SCOPE_AGENT
#define LDS_WAIT() asm volatile("s_waitcnt lgkmcnt(0)" ::: "memory")
#define VM_WAIT() asm volatile("s_waitcnt vmcnt(0)" ::: "memory")
__device__ __forceinline__ unsigned long long rt() { return __builtin_amdgcn_s_memrealtime(); }
__device__ __forceinline__ unsigned f2bf(float f) { unsigned u = __builtin_bit_cast(unsigned, f); return (u + 0x7fffu + ((u >> 16) & 1u)) >> 16; }
__device__ __forceinline__ unsigned pk2(float lo, float hi) { return f2bf(lo) | (f2bf(hi) << 16); }

#define XB_TMO      128
#define XB_XCNT(j)  (256  + 64 * (j))
#define XB_XSUB(j)  (1280 + 64 * (j))
#define XB_XGEN(j)  (2304 + 64 * (j))
#define XB_TOP      3328
#define XB_TOPGEN   3392
#define XCD_BAR_WORDS 3456
#define XB_SPIN_CAP (1u << 18)

__device__ __forceinline__ unsigned xb_ld(unsigned* p)              { return __hip_atomic_load(p, __ATOMIC_RELAXED, __HIP_MEMORY_SCOPE_AGENT); }
__device__ __forceinline__ unsigned xb_add(unsigned* p, unsigned v) { return __hip_atomic_fetch_add(p, v, __ATOMIC_RELAXED, __HIP_MEMORY_SCOPE_AGENT); }
__device__ __forceinline__ unsigned xb_xcc_id() { return (unsigned)__builtin_amdgcn_s_getreg((3 << 11) | 20) & 0xFu; }
#define XB_SPIN(cond, bar) do { unsigned _sp = 0; while (cond) { __builtin_amdgcn_s_sleep(1); \
    if ((++_sp & 255u) == 0u) { if (xb_ld(&(bar)[XB_TMO])) break; if (_sp > XB_SPIN_CAP) { atomicAdd(&(bar)[XB_TMO], 1u); break; } } } } while (0)

struct XcdBarrier {
    unsigned* bar; unsigned x;
    volatile LAS unsigned* st;
};

__device__ __forceinline__ XcdBarrier xcd_barrier_post(unsigned* bar, volatile LAS unsigned* st) {
    XcdBarrier b; b.bar = bar; b.x = xb_xcc_id(); b.st = st;
    if (threadIdx.x == 0) (void)xb_add(&bar[XB_XCNT(b.x)], 1u);
    return b;
}
__device__ __forceinline__ void xcd_barrier_complete(unsigned* bar, unsigned x, unsigned& nloc, unsigned& nx) {
    const unsigned G = gridDim.x * gridDim.y * gridDim.z;
    unsigned sum, cnt, mine, sp = 0u;
    for (;;) {
        sum = 0u; cnt = 0u; mine = 0u;
#pragma unroll
        for (unsigned j = 0; j < 16; ++j) { const unsigned c = xb_ld(&bar[XB_XCNT(j)]); sum += c; cnt += (c > 0u) ? 1u : 0u; mine = (j == x) ? c : mine; }
        if (sum == G) break;
        __builtin_amdgcn_s_sleep(1);
        if ((++sp & 255u) == 0u) { if (xb_ld(&bar[XB_TMO])) break; if (sp > XB_SPIN_CAP) { atomicAdd(&bar[XB_TMO], 1u); break; } }
    }
    nloc = mine > 0u ? mine : 1u; nx = cnt > 0u ? cnt : 1u;
}

__device__ __forceinline__ void xcd_barrier(const XcdBarrier& b) {
    asm volatile("s_waitcnt vmcnt(0)" ::: "memory");
    __syncthreads();
    if (threadIdx.x == 0) {
        unsigned* bar = b.bar;
        __builtin_amdgcn_s_waitcnt(0);
        unsigned nloc = b.st[0], nx = b.st[1];
        if (nloc == 0u) { xcd_barrier_complete(bar, b.x, nloc, nx); b.st[0] = nloc; b.st[1] = nx; }
        const unsigned old = xb_add(&bar[XB_XSUB(b.x)], 1u);
        const unsigned gen = old / nloc;
        if (old + 1u == (gen + 1u) * nloc) {
            __builtin_amdgcn_fence(__ATOMIC_RELEASE, "agent");
            asm volatile("s_waitcnt vmcnt(0)" ::: "memory");
            const unsigned og = xb_add(&bar[XB_TOP], 1u);
            const unsigned tg = og / nx;
            if (og + 1u == (tg + 1u) * nx) xb_add(&bar[XB_TOPGEN], 1u);
            else XB_SPIN(xb_ld(&bar[XB_TOPGEN]) == tg, bar);
            __builtin_amdgcn_fence(__ATOMIC_ACQUIRE, "agent");
            xb_add(&bar[XB_XGEN(b.x)], 1u);
            asm volatile("s_waitcnt vmcnt(0)" ::: "memory");
        } else {
            XB_SPIN(xb_ld(&bar[XB_XGEN(b.x)]) == gen, bar);
            __builtin_amdgcn_fence(__ATOMIC_ACQUIRE, "agent");
            asm volatile("s_waitcnt vmcnt(0)" ::: "memory");
        }
    }
    __syncthreads();
}


constexpr int NB = 4, SEQ = 2048, MT = NB * SEQ, DM = 4096, DFF = 6144;
constexpr int NWAVES = 8, NTHR = 512;
typedef float f32x8 __attribute__((ext_vector_type(8)));
typedef float f32x16 __attribute__((ext_vector_type(16)));
typedef short s16x4 __attribute__((ext_vector_type(4)));
typedef float f32x2v __attribute__((ext_vector_type(2)));
typedef unsigned u32x2v __attribute__((ext_vector_type(2)));

constexpr size_t MiB = (size_t)1 << 20;
constexpr size_t WS_CTL = 0, CTL_BYTES = 2 * MiB;
constexpr size_t WS_T64 = WS_CTL + CTL_BYTES;
constexpr size_t WS_T128 = WS_T64 + (size_t)MT * 32 * 8;
constexpr size_t WS_WFFN = WS_T128 + (size_t)MT * 64 * 8;
constexpr size_t SZ_WGU = (size_t)2 * DFF * DM * 2, SZ_WDN = (size_t)DM * DFF * 2, SZ_FFN = SZ_WGU + SZ_WDN;
constexpr size_t SZ_SQ = (size_t)DM * DM * 2;
constexpr size_t WS_WMLA = WS_WFFN + 8 * SZ_FFN;
constexpr size_t SZ_MLA_IN = (size_t)1792 * 4096 * 2, SZ_MLA_UQ = (size_t)6144 * 1024 * 2, SZ_MLA_UKV = (size_t)8192 * 512 * 2;
constexpr size_t SZ_MLA = SZ_MLA_IN + SZ_MLA_UQ + SZ_MLA_UKV + SZ_SQ;
constexpr size_t WS_WDSA = WS_WMLA + 2 * SZ_MLA;
constexpr size_t SZ_DSA_IN = (size_t)10240 * 4096 * 2, SZ_DSA_NAR = (size_t)256 * 4096 * 2;
constexpr size_t SZ_DSA = SZ_DSA_IN + SZ_DSA_NAR + SZ_SQ;
constexpr size_t WS_WRW = WS_WDSA + SZ_DSA;
constexpr size_t RW_WR = 0, RW_WK = SZ_SQ, RW_WV = 2 * SZ_SQ, RW_WO = 3 * SZ_SQ, RW_W1 = 4 * SZ_SQ, RW_A1 = RW_W1 + 2 * MiB, RW_G1 = RW_A1 + 2 * MiB,
                 RW_W2 = RW_G1 + 4 * MiB, RW_A2 = RW_W2 + 2 * MiB, RW_G2 = RW_A2 + 2 * MiB, SZ_RW = RW_G2 + 4 * MiB;
constexpr size_t WS_XH = WS_WRW + SZ_RW;
constexpr size_t WS_XL = WS_XH + 64 * MiB;
constexpr size_t WS_OB = WS_XL + 64 * MiB;
constexpr size_t WS_SCR = WS_OB + 64 * MiB;
constexpr size_t SC_ACT = 0;
constexpr size_t ML_LAT = 0;
constexpr size_t ML_CQN = ML_LAT + 56 * MiB;
constexpr size_t ML_CKV = ML_CQN + 16 * MiB;
constexpr size_t ML_Q = ML_CKV + 8 * MiB;
constexpr size_t ML_K = ML_Q + 96 * MiB;
constexpr size_t ML_V = ML_K + 96 * MiB;
constexpr size_t ML_END = ML_V + 64 * MiB;
constexpr size_t DS_Q = 0;
constexpr size_t DS_K = DS_Q + 64 * MiB;
constexpr size_t DS_V = DS_K + 16 * MiB;
constexpr size_t DS_QI = DS_V + 16 * MiB;
constexpr size_t DS_KI = DS_QI + 64 * MiB;
constexpr size_t DS_WI = DS_KI + 2 * MiB;
constexpr size_t DS_SC = DS_WI + 1 * MiB;
constexpr size_t DS_KIW = DS_SC;
constexpr size_t DS_MASK = DS_SC + 64 * MiB;
constexpr size_t DS_END = DS_MASK + 2 * MiB;
constexpr size_t RW_XR = 0;
constexpr size_t RW_R = 384 * MiB;
constexpr size_t RW_K = RW_R + 128 * MiB, RW_V = RW_K + 128 * MiB;
constexpr size_t RW_DEC = RW_V + 128 * MiB, RW_AA = RW_DEC + 128 * MiB, RW_G = RW_AA + 128 * MiB;
constexpr size_t RW_TW = RW_G + 128 * MiB;
constexpr size_t RW_LA = RW_TW + 4 * MiB;
constexpr size_t RW_SG = RW_LA + 4 * MiB;
constexpr size_t RW_BON = RW_SG + 8 * MiB;
constexpr size_t RW_NA = 0;
constexpr size_t RW_END = RW_BON + 2 * MiB;
constexpr size_t SCR_BYTES_WS = RW_END > ML_END ? (RW_END > DS_END ? RW_END : DS_END) : (ML_END > DS_END ? ML_END : DS_END);
constexpr size_t WS_END = WS_SCR + SCR_BYTES_WS;
static_assert(WS_END <= (size_t)3351195648ull, "workspace map exceeds sum(inputs) bytes");
static_assert((size_t)MT * DFF * 2 <= SCR_BYTES_WS, "ACT fits");
constexpr int CW_BAR = 4096;
constexpr size_t CTL_RSQ = 65536;
constexpr int N_RSQ = 13;
static_assert((CW_BAR + XCD_BAR_WORDS) * 4 <= (int)CTL_RSQ && CTL_RSQ + (size_t)(N_RSQ + 6) * MT * 8 <= CTL_BYTES, "ctl");
constexpr float RSQ_SCALE = 1048576.0f;
#ifndef RES_LO
#define RES_LO 0
#endif
__device__ __forceinline__ float rsq_rstd(const unsigned long long* rsq, int row) { return __builtin_amdgcn_rsqf((float)rsq[row] * (1.0f / (RSQ_SCALE * DM)) + 1e-6f); }

constexpr int RING_BYTES = 131072;
constexpr int CVT_WAVE_BYTES = 64 * 65 * 4;
constexpr int LDSCTL_OFF = 155648, LDS_BYTES = 163840;
static_assert(NWAVES * CVT_WAVE_BYTES <= LDSCTL_OFF, "lds");

#define WS_DPP(x, ctrl) __builtin_bit_cast(float, __builtin_amdgcn_update_dpp(0, __builtin_bit_cast(int, (x)), (ctrl), 0xF, 0xF, true))
#define WS_DPPM(x, ctrl, rmask) __builtin_bit_cast(float, __builtin_amdgcn_update_dpp(0, __builtin_bit_cast(int, (x)), (ctrl), (rmask), 0xF, false))
__device__ __forceinline__ float row_sum16(float v) {
    v += WS_DPP(v, 0xB1); v += WS_DPP(v, 0x4E); v += WS_DPP(v, 0x141); v += WS_DPP(v, 0x140); return v; }
__device__ __forceinline__ float wave_sum(float v) {
    v = row_sum16(v);
    v += WS_DPPM(v, 0x142, 0xA);
    v += WS_DPPM(v, 0x143, 0xC);
    return __builtin_bit_cast(float, __builtin_amdgcn_readlane(__builtin_bit_cast(int, v), 63));
}
__device__ __forceinline__ unsigned cvtpk(float lo, float hi) { unsigned r; asm volatile("v_cvt_pk_bf16_f32 %0, %1, %2" : "=v"(r) : "v"(lo), "v"(hi)); return r; }
__device__ __forceinline__ float fast_exp(float x) { return __builtin_amdgcn_exp2f(x * 1.4426950408889634f); }
__device__ __forceinline__ float fast_sigmoid(float x) { return __builtin_amdgcn_rcpf(1.0f + fast_exp(-x)); }

using pg8::f32x4; using pg8::u32x4; using pg8::Unit; using pg8::BM; using pg8::HALF;

__device__ __forceinline__ u32x4 pack8(const f32x4 a, const f32x4 b) { u32x4 w; w.x = cvtpk(a[0], a[1]); w.y = cvtpk(a[2], a[3]); w.z = cvtpk(b[0], b[1]); w.w = cvtpk(b[2], b[3]); return w; }
__device__ __forceinline__ f32x4 bf_lo4(const u32x4 w, int half) { const unsigned a = half ? w.z : w.x, b = half ? w.w : w.y;
    return (f32x4){__uint_as_float(a << 16), __uint_as_float(a & 0xffff0000u), __uint_as_float(b << 16), __uint_as_float(b & 0xffff0000u)}; }
struct Rstd8 { float v[2][4]; };
__device__ __forceinline__ Rstd8 rstd8(const unsigned long long* rsq, int row0, float inv = 1.0f / (RSQ_SCALE * DM)) { unsigned long long q[2][4]; Rstd8 r;
#pragma unroll
    for (int ai = 0; ai < 2; ++ai)
#pragma unroll
        for (int m = 0; m < 4; ++m) q[ai][m] = rsq[row0 + ai * HALF + m * 16];
    asm volatile("" ::: "memory");
#pragma unroll
    for (int ai = 0; ai < 2; ++ai)
#pragma unroll
        for (int m = 0; m < 4; ++m) r.v[ai][m] = __builtin_amdgcn_rsqf((float)q[ai][m] * inv + 1e-6f);
    return r; }
struct EpiResid {
    static constexpr bool PERM = true, AFTER_DRAIN = false;
    pg8::bf16_t* XH; pg8::bf16_t* XL; unsigned long long* rsq; float scale;
    __device__ __forceinline__ void operator()(const f32x4 (&acc)[2][2][4][2], const Unit& u, int wr, int wc, int fr, int fq) const {
        const int row0 = u.pm * BM + wr * 64 + fr, col0 = u.pn * BM + wc * 32 + 8 * fq;
#pragma unroll
        for (int ai = 0; ai < 2; ++ai) {
        u32x4 hh[4][2];
#if RES_LO
        u32x4 ll[4][2];
#endif
#pragma unroll
            for (int m = 0; m < 4; ++m)
#pragma unroll
                for (int bj = 0; bj < 2; ++bj) { const size_t off = (size_t)(row0 + ai * HALF + m * 16) * DM + col0 + bj * HALF; hh[m][bj] = *(const u32x4*)(XH + off);
#if RES_LO
                    ll[m][bj] = *(const u32x4*)(XL + off);
#endif
                }
        asm volatile("" ::: "memory");
#pragma unroll
            for (int m = 0; m < 4; ++m) { const int row = row0 + ai * HALF + m * 16; const size_t off = (size_t)row * DM + col0; float ss = 0.f;
#pragma unroll
                for (int bj = 0; bj < 2; ++bj) { u32x4* ph = (u32x4*)(XH + off + bj * HALF); u32x4* pl = (u32x4*)(XL + off + bj * HALF); const u32x4 h = hh[m][bj];
#if RES_LO
                    const u32x4 l = ll[m][bj];
                    f32x4 x0 = bf_lo4(h, 0) + bf_lo4(l, 0) + acc[ai][bj][m][0] * scale, x1 = bf_lo4(h, 1) + bf_lo4(l, 1) + acc[ai][bj][m][1] * scale;
#else
                    f32x4 x0 = bf_lo4(h, 0) + acc[ai][bj][m][0] * scale, x1 = bf_lo4(h, 1) + acc[ai][bj][m][1] * scale; (void)pl;
#endif
                    ss += ((x0[0] * x0[0] + x0[1] * x0[1]) + (x0[2] * x0[2] + x0[3] * x0[3])) + ((x1[0] * x1[0] + x1[1] * x1[1]) + (x1[2] * x1[2] + x1[3] * x1[3]));
                    const u32x4 nh = pack8(x0, x1); *ph = nh;
#if RES_LO
                    *pl = pack8(x0 - bf_lo4(nh, 0), x1 - bf_lo4(nh, 1));
#endif
                }
                ss += __shfl_xor(ss, 16); ss += __shfl_xor(ss, 32);
                if (fq == 0 && scale != 0.f) atomicAdd(rsq + row, (unsigned long long)(ss * RSQ_SCALE + 0.5f)); }
        asm volatile("" ::: "memory");
        }
    }
};
struct EpiF32 {
    static constexpr bool PERM = false, AFTER_DRAIN = false;
    float* C; int ldc; const unsigned long long* rsq;
    __device__ __forceinline__ void operator()(const f32x4 (&acc)[2][2][4][2], const Unit& u, int wr, int wc, int fr, int fq) const {
        const int row0 = u.pm * BM + wr * 64 + fr, col0 = u.pn * BM + wc * 32 + 4 * fq;
        Rstd8 rq; if (rsq) rq = rstd8(rsq, row0);
#pragma unroll
        for (int ai = 0; ai < 2; ++ai)
#pragma unroll
            for (int m = 0; m < 4; ++m) { const int row = row0 + ai * HALF + m * 16; float* rowp = C + (size_t)row * ldc + col0; const float rs = rsq ? rq.v[ai][m] : 1.0f;
#pragma unroll
                for (int bj = 0; bj < 2; ++bj)
#pragma unroll
                    for (int n = 0; n < 2; ++n) *(f32x4*)(rowp + bj * HALF + n * 16) = acc[ai][bj][m][n] * rs; }
    }
};
struct EpiSwiglu {
    static constexpr bool PERM = true, AFTER_DRAIN = false;
    pg8::bf16_t* O; const unsigned long long* rsq;
    __device__ __forceinline__ void operator()(const f32x4 (&acc)[2][2][4][2], const Unit& u, int wr, int wc, int fr, int fq) const {
        const int row0 = u.pm * BM + wr * 64 + fr, col0 = u.pn * HALF + wc * 32 + 8 * fq;
        const Rstd8 rq = rstd8(rsq, row0);
#pragma unroll
        for (int ai = 0; ai < 2; ++ai)
#pragma unroll
            for (int m = 0; m < 4; ++m) { const int row = row0 + ai * HALF + m * 16; const float rs = rq.v[ai][m];
                f32x4 o[2];
#pragma unroll
                for (int n = 0; n < 2; ++n)
#pragma unroll
                    for (int j = 0; j < 4; ++j) { const float g = acc[ai][0][m][n][j] * rs, up = acc[ai][1][m][n][j] * rs; o[n][j] = g * fast_sigmoid(g) * up; }
                *(u32x4*)(O + (size_t)row * DFF + col0) = pack8(o[0], o[1]);
            }
    }
};
__device__ __forceinline__ void rope8(f32x4& a, f32x4& b, const f32x2v* tab) {
    const f32x4 t0 = *(const f32x4*)(tab), t1 = *(const f32x4*)(tab + 2);
    f32x4 ra, rb;
    ra[0] = a[0] * t0[0] - a[1] * t0[1]; ra[1] = a[1] * t0[0] + a[0] * t0[1];
    ra[2] = a[2] * t0[2] - a[3] * t0[3]; ra[3] = a[3] * t0[2] + a[2] * t0[3];
    rb[0] = b[0] * t1[0] - b[1] * t1[1]; rb[1] = b[1] * t1[0] + b[0] * t1[1];
    rb[2] = b[2] * t1[2] - b[3] * t1[3]; rb[3] = b[3] * t1[2] + b[2] * t1[3];
    a = ra; b = rb;
}
__device__ __forceinline__ void rope8v(f32x4& a, f32x4& b, const f32x4 t0, const f32x4 t1) {
    f32x4 ra, rb;
    ra[0] = a[0] * t0[0] - a[1] * t0[1]; ra[1] = a[1] * t0[0] + a[0] * t0[1];
    ra[2] = a[2] * t0[2] - a[3] * t0[3]; ra[3] = a[3] * t0[2] + a[2] * t0[3];
    rb[0] = b[0] * t1[0] - b[1] * t1[1]; rb[1] = b[1] * t1[0] + b[0] * t1[1];
    rb[2] = b[2] * t1[2] - b[3] * t1[3]; rb[3] = b[3] * t1[2] + b[2] * t1[3];
    a = ra; b = rb;
}
struct EpiMlaQ {
    static constexpr bool PERM = true, AFTER_DRAIN = false;
    pg8::bf16_t* Q; const f32x2v* t64; const unsigned long long* rsq;
    __device__ __forceinline__ void operator()(const f32x4 (&acc)[2][2][4][2], const Unit& u, int wr, int wc, int fr, int fq) const {
        const int row0 = u.pm * BM + wr * 64 + fr, cA = u.pn * BM + wc * 32 + 8 * fq, hdA = cA % 192, hdB = (cA + HALF) % 192;
        const Rstd8 rq = rstd8(rsq, row0, 1.0f / (RSQ_SCALE * 1024.0f));
        const bool ropeA = hdA >= 128, ropeB = hdB >= 128;
        const int toff = ((ropeA ? hdA : hdB) - 128) >> 1;
#pragma unroll
        for (int ai = 0; ai < 2; ++ai) {
            f32x4 T0[4], T1[4];
#pragma unroll
            for (int m = 0; m < 4; ++m) { T0[m] = (f32x4){1.f, 0.f, 1.f, 0.f}; T1[m] = T0[m];
                if (ropeA || ropeB) { const f32x2v* tr = t64 + (size_t)(row0 + ai * HALF + m * 16) * 32 + toff; T0[m] = *(const f32x4*)(tr); T1[m] = *(const f32x4*)(tr + 2); } }
            asm volatile("" ::: "memory");
#pragma unroll
            for (int m = 0; m < 4; ++m) { const int row = row0 + ai * HALF + m * 16; pg8::bf16_t* qrow = Q + (size_t)row * 6144 + cA; const float rs = rq.v[ai][m];
                f32x4 a = acc[ai][0][m][0] * rs, b = acc[ai][0][m][1] * rs;
                if (ropeA) rope8v(a, b, T0[m], T1[m]);
                *(u32x4*)(qrow) = pack8(a, b);
                f32x4 c = acc[ai][1][m][0] * rs, d = acc[ai][1][m][1] * rs;
                if (ropeB) rope8v(c, d, T0[m], T1[m]);
                *(u32x4*)(qrow + HALF) = pack8(c, d); }
            asm volatile("" ::: "memory");
        }
    }
};
struct EpiMlaKV {
    static constexpr bool PERM = true, AFTER_DRAIN = false;
    pg8::bf16_t* KF; pg8::bf16_t* VB; const unsigned long long* rsq; const pg8::bf16_t* KR;
    __device__ __forceinline__ void operator()(const f32x4 (&acc)[2][2][4][2], const Unit& u, int wr, int wc, int fr, int fq) const {
        const int row0 = u.pm * BM + wr * 64 + fr, h = u.pn, cc = wc * 32 + 8 * fq;
        const Rstd8 rq = rstd8(rsq, row0, 1.0f / (RSQ_SCALE * 512.0f));
        u32x4 kr[2][4];
        if (wc < 2) {
#pragma unroll
            for (int ai = 0; ai < 2; ++ai)
#pragma unroll
                for (int m = 0; m < 4; ++m) kr[ai][m] = *(const u32x4*)(KR + (size_t)(row0 + ai * HALF + m * 16) * 64 + cc);
        }
        asm volatile("" ::: "memory");
#pragma unroll
        for (int ai = 0; ai < 2; ++ai)
#pragma unroll
            for (int m = 0; m < 4; ++m) { const size_t row = (size_t)(row0 + ai * HALF + m * 16); const float rs = rq.v[ai][m];
                *(u32x4*)(KF + row * 6144 + h * 192 + cc) = pack8(acc[ai][0][m][0] * rs, acc[ai][0][m][1] * rs);
                *(u32x4*)(VB + row * 4096 + h * 128 + cc) = pack8(acc[ai][1][m][0] * rs, acc[ai][1][m][1] * rs); }
        if (wc < 2) {
#pragma unroll
            for (int ai = 0; ai < 2; ++ai)
#pragma unroll
                for (int m = 0; m < 4; ++m) *(u32x4*)(KF + (size_t)(row0 + ai * HALF + m * 16) * 6144 + h * 192 + 128 + cc) = kr[ai][m];
        }
    }
};
struct EpiMlaIn {
    static constexpr bool PERM = true, AFTER_DRAIN = false;
    pg8::bf16_t *CQN, *KF; const f32x2v* t64; const unsigned long long* rsqx; unsigned long long *rsqA;
    __device__ __forceinline__ void operator()(const f32x4 (&acc)[2][2][4][2], const Unit& u, int wr, int wc, int fr, int fq) const {
        const int row0 = u.pm * BM + wr * 64 + fr, pn = u.pn, cc = wc * 32 + 8 * fq;
        const Rstd8 rq = rstd8(rsqx, row0);
        if (pn < 6) {
            static_assert(ML_CKV - ML_CQN == 16 * MiB, "CKV follows CQN");
            pg8::bf16_t* base = CQN + (pn < 4 ? (size_t)0 : (size_t)(8u << 20)); const int ld = pn < 4 ? 1024 : 512, cb = (pn < 4 ? pn : pn - 4) * BM + cc; unsigned long long* rs2 = rsqA + (pn < 4 ? 0 : MT);
#pragma unroll
            for (int ai = 0; ai < 2; ++ai)
#pragma unroll
                for (int m = 0; m < 4; ++m) { const int row = row0 + ai * HALF + m * 16; const float rs = rq.v[ai][m]; pg8::bf16_t* orow = base + (size_t)row * ld + cb;
                    const f32x4 a = acc[ai][0][m][0] * rs, b = acc[ai][0][m][1] * rs, c = acc[ai][1][m][0] * rs, d = acc[ai][1][m][1] * rs;
                    *(u32x4*)(orow) = pack8(a, b); *(u32x4*)(orow + HALF) = pack8(c, d);
                    float ss = (((a[0] * a[0] + a[1] * a[1]) + (a[2] * a[2] + a[3] * a[3])) + ((b[0] * b[0] + b[1] * b[1]) + (b[2] * b[2] + b[3] * b[3])))
                             + (((c[0] * c[0] + c[1] * c[1]) + (c[2] * c[2] + c[3] * c[3])) + ((d[0] * d[0] + d[1] * d[1]) + (d[2] * d[2] + d[3] * d[3])));
                    ss += __shfl_xor(ss, 16); ss += __shfl_xor(ss, 32);
                    if (fq == 0) atomicAdd(rs2 + row, (unsigned long long)(ss * RSQ_SCALE + 0.5f)); }
        } else if (wc < 2) {
#pragma unroll
            for (int ai = 0; ai < 2; ++ai)
#pragma unroll
                for (int m = 0; m < 4; ++m) { const int row = row0 + ai * HALF + m * 16; const float rs = rq.v[ai][m];
                    f32x4 a = acc[ai][0][m][0] * rs, b = acc[ai][0][m][1] * rs;
                    rope8(a, b, t64 + (size_t)row * 32 + (cc >> 1));
                    *(u32x4*)(KF + (size_t)row * 64 + cc) = pack8(a, b); }
        }
    }
};
struct EpiDsaIn {
    static constexpr bool PERM = true, AFTER_DRAIN = false;
    pg8::bf16_t *QD, *KD, *VD, *QI; const f32x2v *t64, *t128; const unsigned long long* rsq;
    __device__ __forceinline__ void operator()(const f32x4 (&acc)[2][2][4][2], const Unit& u, int wr, int wc, int fr, int fq) const {
        const int row0 = u.pm * BM + wr * 64 + fr, pn = u.pn;
        pg8::bf16_t* base; int ld, cbase, mode;
        if (pn < 16) { base = QD; ld = 4096; cbase = pn * BM; mode = 1; }
        else if (pn < 20) { base = KD; ld = 1024; cbase = (pn - 16) * BM; mode = 1; }
        else if (pn < 24) { base = VD; ld = 1024; cbase = (pn - 20) * BM; mode = 0; }
        else { base = QI; ld = 4096; cbase = (pn - 24) * BM; mode = 2; }
        const int c0 = cbase + wc * 32 + 8 * fq, d0 = c0 & 127;
        const bool r64 = mode == 2 && d0 < 64;
        const Rstd8 rq = rstd8(rsq, row0);
        const bool roped = mode == 1 || r64;
        const f32x2v* tbase = mode == 1 ? t128 + (d0 >> 1) : t64 + (d0 >> 1); const int tld = mode == 1 ? 64 : 32;
#pragma unroll
        for (int ai = 0; ai < 2; ++ai) {
            f32x4 T0[4], T1[4];
#pragma unroll
            for (int m = 0; m < 4; ++m) { T0[m] = (f32x4){1.f, 0.f, 1.f, 0.f}; T1[m] = T0[m];
                if (roped) { const f32x2v* tr = tbase + (size_t)(row0 + ai * HALF + m * 16) * tld; T0[m] = *(const f32x4*)(tr); T1[m] = *(const f32x4*)(tr + 2); } }
            asm volatile("" ::: "memory");
#pragma unroll
            for (int m = 0; m < 4; ++m) { const int row = row0 + ai * HALF + m * 16; pg8::bf16_t* orow = base + (size_t)row * ld + c0; const float rs = rq.v[ai][m];
                f32x4 a = acc[ai][0][m][0] * rs, b = acc[ai][0][m][1] * rs, c = acc[ai][1][m][0] * rs, d = acc[ai][1][m][1] * rs;
                if (roped) { rope8v(a, b, T0[m], T1[m]); rope8v(c, d, T0[m], T1[m]); }
                if (mode == 2) {
                    pg8::bf16_t* q = QI + ((size_t)(row >> 5) * 32 + (c0 >> 7)) * 4096 + ((((d0 >> 4) * 2 + ((d0 >> 3) & 1)) * 32 + (row & 31)) * 8);
                    *(u32x4*)(q) = pack8(a, b); *(u32x4*)(q + 4096) = pack8(c, d);
                } else { *(u32x4*)(orow) = pack8(a, b); *(u32x4*)(orow + HALF) = pack8(c, d); }
            }
            asm volatile("" ::: "memory");
        }
    }
};
struct EpiRw2 {
    static constexpr bool PERM = false, AFTER_DRAIN = false;
    float* C; const float* vec; int mode;
    __device__ __forceinline__ void operator()(const f32x4 (&acc)[2][2][4][2], const Unit& u, int wr, int wc, int fr, int fq) const {
        const int row0 = u.pm * BM + wr * 64 + fr, col0 = u.pn * BM + wc * 32 + 4 * fq;
        f32x4 bvs[2][2];
#pragma unroll
        for (int bj = 0; bj < 2; ++bj)
#pragma unroll
            for (int n = 0; n < 2; ++n) { bvs[bj][n] = (f32x4){0.f, 0.f, 0.f, 0.f}; if (mode != 2) bvs[bj][n] = *(const f32x4*)(vec + col0 + bj * HALF + n * 16); }
        asm volatile("" ::: "memory");
#pragma unroll
        for (int bj = 0; bj < 2; ++bj)
#pragma unroll
            for (int n = 0; n < 2; ++n) { const int c = col0 + bj * HALF + n * 16; const f32x4 bv = bvs[bj][n];
#pragma unroll
                for (int ai = 0; ai < 2; ++ai)
#pragma unroll
                    for (int m = 0; m < 4; ++m) { f32x4 v = acc[ai][bj][m][n] + bv;
                        if (mode == 0) {
#pragma unroll
                            for (int j = 0; j < 4; ++j) { const float z = -v[j];
                                const float sp = fmaxf(z, 0.f) + __logf(1.0f + fast_exp(-fabsf(z)));
                                v[j] = fast_exp(-fast_exp(-sp - 0.5f)); }
                        } else if (mode == 1) {
#pragma unroll
                            for (int j = 0; j < 4; ++j) v[j] = fast_sigmoid(v[j]);
                        }
                        if (mode == 2) *(unsigned long long*)((pg8::bf16_t*)C + (size_t)(row0 + ai * HALF + m * 16) * DM + c) = (unsigned long long)cvtpk(v[0], v[1]) | ((unsigned long long)cvtpk(v[2], v[3]) << 32);
                        else *(f32x4*)(C + (size_t)(row0 + ai * HALF + m * 16) * DM + c) = v; }
            }
    }
};

struct JobOrder : pg8::StaticOrder {
    size_t a_stride; unsigned a_sel;
    __device__ __forceinline__ size_t a_off(const Unit& u) const { return (size_t)((a_sel >> (4 * (u.pn & 7))) & 15u) * a_stride; }
};
struct SplitKOrder {
    static constexpr int LDA = DM;
    int G, c;
    __device__ bool next(int i, Unit& u) const { const int L = i * G + c; if (L >= 32 * 8) return false; u.pm = L & 31; u.pn = L >> 5; return true; }
    __device__ __forceinline__ size_t a_off(const Unit& u) const { return (size_t)u.pn * 512 * 2; }
    __device__ __forceinline__ void a_ready(const Unit&) const {}
    __device__ __forceinline__ void done(const Unit&) const {}
};
struct EpiRwNarrow {
    static constexpr bool PERM = true, AFTER_DRAIN = false;
    pg8::bf16_t *TW;
    __device__ __forceinline__ void operator()(const f32x4 (&acc)[2][2][4][2], const Unit& u, int wr, int wc, int fr, int fq) const {
        const int row0 = u.pm * BM + wr * 64 + fr, pn = u.pn;
        pg8::bf16_t* O = TW + (size_t)(pn < 2 ? pn : 2) * (2u << 20); const int ldc = pn < 2 ? 256 : 512, cb = pn == 3 ? 256 : 0, act = pn == 0 ? 1 : (pn == 1 ? 0 : 2);
#pragma unroll
        for (int bj = 0; bj < 2; ++bj) {
            const int c0 = cb + bj * HALF + wc * 32 + 8 * fq;
#pragma unroll
            for (int ai = 0; ai < 2; ++ai)
#pragma unroll
                for (int m = 0; m < 4; ++m) { f32x4 v[2] = {acc[ai][bj][m][0], acc[ai][bj][m][1]};
                    if (act == 1) {
#pragma unroll
                        for (int n = 0; n < 2; ++n)
#pragma unroll
                            for (int j = 0; j < 4; ++j) { const float x = v[n][j], e = fast_exp(-2.0f * fabsf(x)), t = (1.0f - e) * __builtin_amdgcn_rcpf(1.0f + e); v[n][j] = x < 0.f ? -t : t; }
                    } else if (act == 2) {
#pragma unroll
                        for (int n = 0; n < 2; ++n)
#pragma unroll
                            for (int j = 0; j < 4; ++j) v[n][j] = fast_sigmoid(v[n][j]);
                    }
                    *(u32x4*)(O + (size_t)(row0 + ai * HALF + m * 16) * ldc + c0) = pack8(v[0], v[1]); }
        }
    }
};
template <class T> __device__ __forceinline__ T* uni(T* p) { const unsigned long long v = (unsigned long long)p;
    const unsigned lo = __builtin_amdgcn_readfirstlane((unsigned)v), hi = __builtin_amdgcn_readfirstlane((unsigned)(v >> 32)); return (T*)(GAS T*)(((unsigned long long)hi << 32) | lo); }
__device__ __forceinline__ int uni(int v) { return __builtin_amdgcn_readfirstlane(v); }
#define THIN_FN __device__ __noinline__

struct DstNat { bf16* base; int ld; int N;
    __device__ __forceinline__ bf16* operator()(int n, int = 0) const { if (n >= N) return nullptr;
        if (N == 1600 && n >= 1536) { const int i = n - 1536; n = 1536 + (i < 32 ? 2 * i : 2 * (i - 32) + 1); }
        return base + (size_t)n * ld; } };
struct DstGU { bf16* base;
    __device__ __forceinline__ bf16* operator()(int n, int = 0) const { const int up = n >= DFF, j = up ? n - DFF : n; return base + (size_t)(256 * (j >> 7) + 128 * up + (j & 127)) * DM; } };
struct DstUQ { bf16* base;
    __device__ __forceinline__ bf16* operator()(int n, int = 0) const { const int h = n / 192; int d = n - h * 192;
        if (d >= 128) { const int i = d - 128; d = 128 + (i < 32 ? 2 * i : 2 * (i - 32) + 1); }
        return base + (size_t)(h * 192 + d) * 1024; } };
struct DstDsaIn { bf16* main; bf16* nar;
    __device__ __forceinline__ bf16* operator()(int n, int k0 = 0) const {
        if (n >= 10400) return nullptr;
        if (n < 5120) { const int d = n & 127, dd = d < 64 ? 2 * d : 2 * (d - 64) + 1; return main + (size_t)((n & ~127) + dd) * DM; }
        if (n < 6144) return main + (size_t)n * DM;
        const size_t nk = (size_t)(k0 >> 9) * (256 * 512 - 512);
        if (n < 10368) { const int d = n & 127, dd = d < 32 ? 2 * d : (d < 64 ? 2 * (d - 32) + 1 : d);
            return n < 10240 ? main + (size_t)((n & ~127) + dd) * DM : nar + (size_t)dd * 512 + nk; }
        return nar + (size_t)(128 + n - 10368) * 512 + nk; } };

template <class Dst>
__device__ __forceinline__ void cvt_tile(const float* __restrict__ W, const float* __restrict__ gain, int Ksrc, int N, int k0, int n0, LAS float* scr, int lane, const Dst& dst) {
    const int kr = lane >> 4, nc = (lane & 15) * 4;
    f32x4 v[16];
#pragma unroll
    for (int i = 0; i < 16; ++i) { const int k = k0 + 4 * i + kr, n = n0 + nc;
        v[i] = (f32x4){0.f, 0.f, 0.f, 0.f};
        if (k < Ksrc && n < N) { v[i] = __builtin_nontemporal_load((const f32x4*)(W + (size_t)k * N + n)); if (gain) v[i] = v[i] * gain[k]; } }
#pragma unroll
    for (int i = 0; i < 16; ++i) { LAS float* s = scr + (4 * i + kr) * 65 + nc; s[0] = v[i][0]; s[1] = v[i][1]; s[2] = v[i][2]; s[3] = v[i][3]; }
    LDS_WAIT(); asm volatile("" ::: "memory");
    const int c = lane & 7;
#pragma unroll
    for (int j = 0; j < 8; ++j) { const int nl = (lane >> 3) + 8 * j; const LAS float* s = scr + (8 * c) * 65 + nl;
        v4u o; o.x = cvtpk(s[0], s[65]); o.y = cvtpk(s[2 * 65], s[3 * 65]); o.z = cvtpk(s[4 * 65], s[5 * 65]); o.w = cvtpk(s[6 * 65], s[7 * 65]);
        bf16* d = dst(n0 + nl, k0);
        if (d) *(v4u*)(d + k0 + 8 * c) = o; }
    LDS_WAIT(); asm volatile("" ::: "memory");
}
struct DstAny { int mode; bf16* base; bf16* base2; int ld; int N;
    __device__ __forceinline__ bf16* operator()(int n, int k0 = 0) const {
        if (mode == 0) return DstNat{base, ld, N}(n);
        if (mode == 1) return DstGU{base}(n);
        if (mode == 2) return DstUQ{base}(n);
        return DstDsaIn{base, base2}(n, k0); } };
THIN_FN int cvt_matrix_any(const float* W, const float* gain, int Ksrc, int Kdst, int N, int mode, bf16* base, bf16* base2, int ld, int gw, int ngw, int rot, LAS float* scr, int lane) {
    W = uni(W); gain = uni(gain); Ksrc = uni(Ksrc); Kdst = uni(Kdst); N = uni(N); mode = uni(mode); base = uni(base); base2 = uni(base2); ld = uni(ld); gw = uni(gw); ngw = uni(ngw); rot = uni(rot);
    scr = (LAS float*)(unsigned)uni((int)(unsigned)(uintptr_t)scr);
    const DstAny dst{mode, base, base2, ld, N};
    const int nnb = (N + 63) / 64, cnt = (Kdst / 64) * nnb;
    int first = gw - rot; if (first < 0) first += ngw;
    for (int it = first; it < cnt; it += ngw) { const int kb = it / nnb, nb = it - kb * nnb; cvt_tile(W, gain, Ksrc, N, kb * 64, nb * 64, scr, lane, dst); }
    return (rot + cnt) % ngw;
}
THIN_FN void zero_bytes(void* p, unsigned bytes, int gtid, int gthreads) {
    v4u* q = (v4u*)uni(p); const unsigned n = uni((int)bytes) / 16u;
    for (unsigned i = gtid; i < n; i += gthreads) q[i] = (v4u){0u, 0u, 0u, 0u};
}
__device__ __forceinline__ void sincos_acc(float ang, float& c, float& s) {
    double r = (double)ang; r -= 6.283185307179586476925 * __builtin_rint(r * 0.15915494309189533577);
    const double r2 = r * r;
    double sn = 1.0, cs = 1.0;
#pragma unroll
    for (int k = 12; k >= 1; --k) { sn = 1.0 - sn * r2 / (double)((2 * k) * (2 * k + 1)); cs = 1.0 - cs * r2 / (double)((2 * k - 1) * (2 * k)); }
    s = (float)(sn * r); c = (float)cs;
}
__device__ __forceinline__ void rope_tables(const int* pos, f32x2v* t64, f32x2v* t128, int gtid, int gthreads) {
    pos = uni(pos); t64 = uni(t64); t128 = uni(t128);
    for (int idx = gtid; idx < MT * 96; idx += gthreads) { const int tok = idx / 96, i = idx - tok * 96;
        const bool big = i >= 32; const int ii = big ? i - 32 : i;
        const double e = big ? (double)(2 * ii) / 128.0 : (double)(2 * ii) / 64.0;
        const float inv = (float)exp2(-e * 13.287712379549449);
        const float ang = (float)pos[tok] * inv;
        float c, s; sincos_acc(ang, c, s);
        (big ? t128 + (size_t)tok * 64 : t64 + (size_t)tok * 32)[ii] = (f32x2v){c, s}; }
}

__device__ __forceinline__ unsigned long long pk4(float a, float b, float c, float d) { return (unsigned long long)cvtpk(a, b) | ((unsigned long long)cvtpk(c, d) << 32); }
__device__ __forceinline__ f32x4 unpk4(unsigned long long w) { const unsigned a = (unsigned)w, b = (unsigned)(w >> 32);
    return (f32x4){__uint_as_float(a << 16), __uint_as_float(a & 0xffff0000u), __uint_as_float(b << 16), __uint_as_float(b & 0xffff0000u)}; }
THIN_FN void phase_split_x(const float* X, bf16* XH, bf16* XL, unsigned long long* rsq, int gw, int ngw, int lane) {
    X = uni(X); XH = uni(XH); XL = uni(XL); rsq = uni(rsq); gw = uni(gw); ngw = uni(ngw);
    for (int m = gw; m < MT; m += ngw) { const f32x4* xr = (const f32x4*)(X + (size_t)m * DM) + lane; float s = 0.f;
        unsigned long long* oh = (unsigned long long*)(XH + (size_t)m * DM) + lane; unsigned long long* ol = (unsigned long long*)(XL + (size_t)m * DM) + lane;
#pragma unroll
        for (int jb = 0; jb < 16; jb += 8) { f32x4 vv[8];
#pragma unroll
            for (int j = 0; j < 8; ++j) vv[j] = xr[64 * (jb + j)];
            asm volatile("" ::: "memory");
#pragma unroll
            for (int j = 0; j < 8; ++j) { const f32x4 v = vv[j]; s += (v[0] * v[0] + v[1] * v[1]) + (v[2] * v[2] + v[3] * v[3]);
                const unsigned long long h = pk4(v[0], v[1], v[2], v[3]); oh[64 * (jb + j)] = h;
#if RES_LO
                { const f32x4 r = v - unpk4(h); ol[64 * (jb + j)] = pk4(r[0], r[1], r[2], r[3]); }
#else
                (void)ol;
#endif
            }
            asm volatile("" ::: "memory"); }
        s = wave_sum(s); if (lane == 0) rsq[m] = (unsigned long long)(s * RSQ_SCALE + 0.5f); }
}
THIN_FN void phase_final_norm(const bf16* XH, const bf16* XL, const unsigned long long* rsq, float* O, const float* gain, int gw, int ngw, int lane) {
    XH = uni(XH); XL = uni(XL); rsq = uni(rsq); O = uni(O); gain = uni(gain); gw = uni(gw); ngw = uni(ngw); (void)XL;
    static_assert(RES_LO == 0, "phase_final_norm reads the bf16 residual plane only");
    for (int m = gw; m < MT; m += ngw) { const float rstd = rsq_rstd(rsq, m);
        const unsigned long long* xh = (const unsigned long long*)(XH + (size_t)m * DM) + lane;
        f32x4* orow = (f32x4*)(O + (size_t)m * DM) + lane;
#pragma unroll
        for (int jb = 0; jb < 16; jb += 8) { unsigned long long xr[8]; f32x4 g[8];
#pragma unroll
            for (int j = 0; j < 8; ++j) { xr[j] = xh[64 * (jb + j)]; g[j] = ((const f32x4*)gain + lane)[64 * (jb + j)]; }
            asm volatile("" ::: "memory");
#pragma unroll
            for (int j = 0; j < 8; ++j) orow[64 * (jb + j)] = unpk4(xr[j]) * rstd * g[j];
            asm volatile("" ::: "memory"); } }
}
THIN_FN void phase_mla_latnorm(const float* LAT, const float* qn, const float* kvn, const f32x2v* t64, bf16* CQN, bf16* CKV, bf16* KF, int gw, int ngw, int lane) {
    LAT = uni(LAT); qn = uni(qn); kvn = uni(kvn); t64 = uni(t64); CQN = uni(CQN); CKV = uni(CKV); KF = uni(KF); gw = uni(gw); ngw = uni(ngw);
    for (int m = gw; m < MT; m += ngw) { const float* lr = LAT + (size_t)m * 1792;
        f32x4 a[4], b[2]; float sa = 0.f, sb = 0.f;
#pragma unroll
        for (int j = 0; j < 4; ++j) { a[j] = ((const f32x4*)lr + lane)[64 * j]; sa += (a[j][0] * a[j][0] + a[j][1] * a[j][1]) + (a[j][2] * a[j][2] + a[j][3] * a[j][3]); }
#pragma unroll
        for (int j = 0; j < 2; ++j) { b[j] = ((const f32x4*)(lr + 1024) + lane)[64 * j]; sb += (b[j][0] * b[j][0] + b[j][1] * b[j][1]) + (b[j][2] * b[j][2] + b[j][3] * b[j][3]); }
        const float ra = 1.0f / sqrtf(wave_sum(sa) * (1.0f / 1024.0f) + 1e-6f), rb = 1.0f / sqrtf(wave_sum(sb) * (1.0f / 512.0f) + 1e-6f);
#pragma unroll
        for (int j = 0; j < 4; ++j) { const f32x4 g = ((const f32x4*)qn + lane)[64 * j];
            ((unsigned long long*)(CQN + (size_t)m * 1024) + lane)[64 * j] = pk4(a[j][0] * ra * g[0], a[j][1] * ra * g[1], a[j][2] * ra * g[2], a[j][3] * ra * g[3]); }
#pragma unroll
        for (int j = 0; j < 2; ++j) { const f32x4 g = ((const f32x4*)kvn + lane)[64 * j];
            ((unsigned long long*)(CKV + (size_t)m * 512) + lane)[64 * j] = pk4(b[j][0] * rb * g[0], b[j][1] * rb * g[1], b[j][2] * rb * g[2], b[j][3] * rb * g[3]); }
        const int i = lane & 31; const float x1 = lr[1536 + i], x2 = lr[1568 + i]; const f32x2v cs = t64[(size_t)m * 32 + i];
        const unsigned w = cvtpk(x1 * cs[0] - x2 * cs[1], x2 * cs[0] + x1 * cs[1]);
        unsigned* kr = (unsigned*)(KF + (size_t)m * 6144 + 128) + i;
#pragma unroll
        for (int hh = 0; hh < 16; ++hh) kr[(2 * hh + (lane >> 5)) * 96] = w;
    }
}
THIN_FN void phase_dsa_kiw(const float* KIW, const f32x2v* t64, bf16* KI, float* WI, int gw, int ngw, int lane) {
    KIW = uni(KIW); t64 = uni(t64); KI = uni(KI); WI = uni(WI); gw = uni(gw); ngw = uni(ngw);
    for (int m = gw; m < MT; m += ngw) { const float* r = KIW + (size_t)m * 2048;
        f32x2v x = *(const f32x2v*)(r + 2 * lane);
        float wi = lane < 32 ? r[128 + lane] : 0.f;
#pragma unroll
        for (int ks = 1; ks < 8; ++ks) { x += *(const f32x2v*)(r + ks * 256 + 2 * lane); if (lane < 32) wi += r[ks * 256 + 128 + lane]; }
        float o0 = x[0], o1 = x[1];
        if (lane < 32) { const f32x2v cs = t64[(size_t)m * 32 + lane]; o0 = x[0] * cs[0] - x[1] * cs[1]; o1 = x[1] * cs[0] + x[0] * cs[1]; }
        *(unsigned*)(KI + (size_t)(m >> 5) * 4096 + ((((lane >> 3) * 2 + ((lane >> 2) & 1)) * 32 + (m & 31)) * 8) + 2 * (lane & 3)) = cvtpk(o0, o1);
        if (lane < 32) WI[(size_t)(m >> 5) * 1024 + lane * 32 + (m & 31)] = wi * 0.015625f;
    }
}
THIN_FN void phase_rwkv_mix(const bf16* XH, const bf16* XL, const unsigned long long* rsq, const float* gain, const float* mu, bf16* XM, int gw, int ngw, int lane) {
    XH = uni(XH); XL = uni(XL); rsq = uni(rsq); gain = uni(gain); mu = uni(mu); XM = uni(XM); gw = uni(gw); ngw = uni(ngw); (void)XL;
    static_assert(RES_LO == 0, "phase_rwkv_mix reads the bf16 residual plane only");
    constexpr unsigned RPW = 4;
    for (unsigned it = gw; it < MT / RPW; it += ngw) { const unsigned m0 = it * RPW; const bool first = (m0 & (SEQ - 1)) == 0;
        float rs[RPW + 1];
        rs[0] = first ? 0.f : rsq_rstd(rsq, (int)m0 - 1);
#pragma unroll
        for (unsigned r = 0; r < RPW; ++r) rs[r + 1] = rsq_rstd(rsq, (int)(m0 + r));
#pragma unroll 1
        for (unsigned j = 0; j < 8; ++j) { const unsigned c = 8 * lane + 512 * j, e0 = m0 * DM + c;
            const f32x4 g0 = *(const f32x4*)(gain + c), g1 = *(const f32x4*)(gain + c + 4);
            u32x4 hr[RPW + 1];
            hr[0] = *(const u32x4*)(XH + (first ? e0 : e0 - DM));
#pragma unroll
            for (unsigned r = 0; r < RPW; ++r) hr[r + 1] = *(const u32x4*)(XH + (e0 + r * DM));
            f32x4 ma0 = *(const f32x4*)(mu + c), ma1 = *(const f32x4*)(mu + c + 4);
            f32x4 hc0[RPW + 1], hc1[RPW + 1];
#pragma unroll
            for (unsigned r = 0; r <= RPW; ++r) { hc0[r] = bf_lo4(hr[r], 0) * rs[r] * g0; hc1[r] = bf_lo4(hr[r], 1) * rs[r] * g1; }
#pragma unroll
            for (unsigned s = 0; s < 6; ++s) { f32x4 mb0 = ma0, mb1 = ma1;
                if (s + 1 < 6) { mb0 = *(const f32x4*)(mu + ((s + 1) * DM + c)); mb1 = *(const f32x4*)(mu + ((s + 1) * DM + c + 4)); }
#pragma unroll
                for (unsigned r = 0; r < RPW; ++r)
                    *(u32x4*)(XM + ((size_t)s * MT * DM + (e0 + r * DM))) = pack8(hc0[r + 1] + (hc0[r] - hc0[r + 1]) * ma0, hc1[r + 1] + (hc1[r] - hc1[r + 1]) * ma1);
                ma0 = mb0; ma1 = mb1; }
        }
    }
}

namespace att {
#define ATT_SBAR() __builtin_amdgcn_sched_barrier(0)
__device__ __forceinline__ int crow(int r, int hi) { return (r & 3) + 8 * (r >> 2) + 4 * hi; }
__device__ __forceinline__ int v_st(int k, int c) { const int kk = (k & ~0xC) | ((k & 4) << 1) | ((k & 8) >> 1); return ((kk >> 3) * 4 + (c >> 5)) * 512 + ((kk & 7) * 32 + (c & 31)) * 2; }
__device__ __forceinline__ int v_rd_base(int lane) { return ((lane & 3) << 3) | (((lane >> 2) & 3) << 6) | (((lane >> 4) & 1) << 5) | (((lane >> 5) & 1) << 8); }
constexpr int v_rd_off(int d0, int ks, int half) { return d0 * 512 + ks * 4096 + half * 2048; }
template <int OFF> __device__ __forceinline__ s16x4 tr_read(int vb) { s16x4 r; asm volatile("ds_read_b64_tr_b16 %0, %1 offset:%2" : "=&v"(r) : "v"(vb), "i"(OFF) : "memory"); return r; }
template <int D0> __device__ __forceinline__ void pv_one(f32x16& od, int vb, bf16x8 pa0, bf16x8 pa1, bf16x8 pa2, bf16x8 pa3) {
    const s16x4 l0 = tr_read<v_rd_off(D0, 0, 0)>(vb), h0 = tr_read<v_rd_off(D0, 0, 1)>(vb), l1 = tr_read<v_rd_off(D0, 1, 0)>(vb), h1 = tr_read<v_rd_off(D0, 1, 1)>(vb);
    const s16x4 l2 = tr_read<v_rd_off(D0, 2, 0)>(vb), h2 = tr_read<v_rd_off(D0, 2, 1)>(vb), l3 = tr_read<v_rd_off(D0, 3, 0)>(vb), h3 = tr_read<v_rd_off(D0, 3, 1)>(vb);
    asm volatile("s_waitcnt lgkmcnt(0)" ::: "memory"); ATT_SBAR();
#define ATT_PK(L, H) (bf16x8){L[0], L[1], L[2], L[3], H[0], H[1], H[2], H[3]}
    od = __builtin_amdgcn_mfma_f32_32x32x16_bf16(pa0, ATT_PK(l0, h0), od, 0, 0, 0);
    od = __builtin_amdgcn_mfma_f32_32x32x16_bf16(pa1, ATT_PK(l1, h1), od, 0, 0, 0);
    od = __builtin_amdgcn_mfma_f32_32x32x16_bf16(pa2, ATT_PK(l2, h2), od, 0, 0, 0);
    od = __builtin_amdgcn_mfma_f32_32x32x16_bf16(pa3, ATT_PK(l3, h3), od, 0, 0, 0);
#undef ATT_PK
}
__device__ __forceinline__ void pv_d0(f32x16* o, int vb, bf16x8 pa0, bf16x8 pa1, bf16x8 pa2, bf16x8 pa3) {
    pv_one<0>(o[0], vb, pa0, pa1, pa2, pa3); pv_one<1>(o[1], vb, pa0, pa1, pa2, pa3); pv_one<2>(o[2], vb, pa0, pa1, pa2, pa3); pv_one<3>(o[3], vb, pa0, pa1, pa2, pa3);
}
template <bool MASKED>
__device__ __forceinline__ void partialSM(f32x16& p0, f32x16& p1, float& m_reg, float& mn, float& alpha, float C, float THRS, bool tile_valid, u32x2v mk, int hi) {
    const float NINF = -__builtin_inff();
    if (MASKED) { const unsigned b0 = tile_valid ? (mk[0] >> (4 * hi)) : 0u, b1 = tile_valid ? (mk[1] >> (4 * hi)) : 0u;
#pragma unroll
        for (int r = 0; r < 16; ++r) { const int sh = (r & 3) + 8 * (r >> 2); p0[r] = ((b0 >> sh) & 1u) ? p0[r] : NINF; p1[r] = ((b1 >> sh) & 1u) ? p1[r] : NINF; }
    } else if (!tile_valid) {
#pragma unroll
        for (int r = 0; r < 16; ++r) { p0[r] = NINF; p1[r] = NINF; }
    }
    float pmax = p0[0];
#pragma unroll
    for (int r = 1; r < 16; ++r) pmax = fmaxf(pmax, p0[r]);
#pragma unroll
    for (int r = 0; r < 16; ++r) pmax = fmaxf(pmax, p1[r]);
    { auto rr = __builtin_amdgcn_permlane32_swap(__float_as_uint(pmax), __float_as_uint(pmax), false, false); pmax = fmaxf(__uint_as_float(rr[0]), __uint_as_float(rr[1])); }
    if (__builtin_expect(__all(pmax - m_reg <= THRS), 1)) { mn = m_reg; alpha = 1.f; }
    else { mn = fmaxf(m_reg, pmax); alpha = __builtin_amdgcn_exp2f((m_reg - mn) * C); m_reg = mn; }
    const float mnC = -mn * C;
#pragma unroll
    for (int r = 0; r < 16; ++r) p0[r] = fmaf(p0[r], C, mnC);
#pragma unroll
    for (int r = 0; r < 16; ++r) p1[r] = fmaf(p1[r], C, mnC);
#pragma unroll
    for (int r = 0; r < 16; ++r) p0[r] = __builtin_amdgcn_exp2f(p0[r]);
}
__device__ __forceinline__ void finishSM(f32x16& p0, f32x16& p1, float alpha, float& l_reg, bf16x8& pa0, bf16x8& pa1, bf16x8& pa2, bf16x8& pa3) {
#pragma unroll
    for (int r = 0; r < 16; ++r) p1[r] = __builtin_amdgcn_exp2f(p1[r]);
    float ps = 0;
#pragma unroll
    for (int r = 0; r < 16; ++r) ps += p0[r];
#pragma unroll
    for (int r = 0; r < 16; ++r) ps += p1[r];
    { auto rr = __builtin_amdgcn_permlane32_swap(__float_as_uint(ps), __float_as_uint(ps), false, false); ps = __uint_as_float(rr[0]) + __uint_as_float(rr[1]); }
    l_reg = l_reg * alpha + ps;
#define ATT_PK4(P, BASE, OUT) do { unsigned a0 = cvtpk(P[BASE + 0], P[BASE + 1]), a1 = cvtpk(P[BASE + 2], P[BASE + 3]);   \
    unsigned b0 = cvtpk(P[BASE + 4], P[BASE + 5]), b1 = cvtpk(P[BASE + 6], P[BASE + 7]);                              \
    auto r0 = __builtin_amdgcn_permlane32_swap(a0, b0, false, false); auto r1 = __builtin_amdgcn_permlane32_swap(a1, b1, false, false); \
    u32x4 w = {r0[0], r1[0], r0[1], r1[1]}; OUT = *reinterpret_cast<bf16x8*>(&w); } while (0)
    ATT_PK4(p0, 0, pa0); ATT_PK4(p0, 8, pa1); ATT_PK4(p1, 0, pa2); ATT_PK4(p1, 8, pa3);
#undef ATT_PK4
}
template <int DQK, int LDQ, int LDK, int LDV, bool MASKED>
__device__ __forceinline__ void attn_unit(const bf16* __restrict__ Qb, const bf16* __restrict__ Kh, const bf16* __restrict__ Vh, bf16* __restrict__ Ob,
                                          const unsigned* __restrict__ mask0, int qb, float C, float THRS, char* lds, int wave_s) {
    constexpr int KROW = DQK * 2, SHM_K = 64 * KROW, SHM_V = 64 * 128 * 2, NQF = DQK / 16, KCH = DQK / 8, KST = DQK / 64;
#define ATT_KSWZ(row, colB) ((row) * KROW + ((colB) ^ (((row) & 7) << 4)))
    const int tid = opaque_tid_w(wave_s), wid = wave_s, lane = tid & 63, r32 = lane & 31, hi = lane >> 5;
    char* V_lds = lds; char* K_lds = lds + 3 * SHM_V;
    float* wsf = (float*)(lds + 3 * SHM_V + 3 * SHM_K) + wid * 64; float* li_l = wsf; float* al_l = wsf + 32;
    const int NT = 4 * (qb + 1), lim = 4 * qb + (wid >> 1) + 1;
    float m_reg = -1e30f, l_reg = 0; f32x16 o[4] = {}; bf16x8 qr[NQF];
    const bf16* Qw = Qb + (size_t)(wid * 32 + r32) * LDQ + hi * 8;
#pragma unroll
    for (int d0 = 0; d0 < NQF; ++d0) qr[d0] = *(const bf16x8*)(Qw + d0 * 16);
    const unsigned* mrow = MASKED ? mask0 + (size_t)(wid * 32 + r32) * 64 : nullptr;
    int voff[2], koff[KST];
#pragma unroll
    for (int i = 0; i < 2; ++i) { const int L = (tid + 512 * i) * 16, st = L >> 9, w = (L & 511) >> 1, kk = ((st >> 2) << 3) | (w >> 5), c = ((st & 3) << 5) | (w & 31);
        const int k = (kk & ~0xC) | ((kk & 4) << 1) | ((kk & 8) >> 1); voff[i] = k * LDV + c; }
#pragma unroll
    for (int i = 0; i < KST; ++i) { const int L = (tid + 512 * i) * 16, row = L / KROW, cb = (L - row * KROW) ^ ((row & 7) << 4); koff[i] = row * LDK + (cb >> 1); }
    const int vb0 = (int)(uintptr_t)V_lds + v_rd_base(lane);
    typedef __attribute__((address_space(3))) unsigned lds_u32;
#define ATT_STAGE(k0, b) do { \
    _Pragma("unroll") for (int _i = 0; _i < 2; ++_i) __builtin_amdgcn_global_load_lds((const unsigned*)(Vh + (size_t)(k0) * LDV + voff[_i]), (lds_u32*)(V_lds + (b) * SHM_V + wid * 1024 + _i * 8192), 16, 0, 0); \
    _Pragma("unroll") for (int _i = 0; _i < KST; ++_i) __builtin_amdgcn_global_load_lds((const unsigned*)(Kh + (size_t)(k0) * LDK + koff[_i]), (lds_u32*)(K_lds + (b) * SHM_K + wid * 1024 + _i * 8192), 16, 0, 0); } while (0)
#define ATT_QKT(P0, P1, b) do { P0 = f32x16{}; P1 = f32x16{}; const char* _Ks = K_lds + (b) * SHM_K; \
    _Pragma("unroll") for (int d0 = 0; d0 < NQF; ++d0) { const int cb = (d0 * 16 + hi * 8) * 2; \
        const bf16x8 b0 = *(const bf16x8*)(_Ks + ATT_KSWZ(r32, cb)); const bf16x8 b1 = *(const bf16x8*)(_Ks + ATT_KSWZ(32 + r32, cb)); \
        P0 = __builtin_amdgcn_mfma_f32_32x32x16_bf16(b0, qr[d0], P0, 0, 0, 0); P1 = __builtin_amdgcn_mfma_f32_32x32x16_bf16(b1, qr[d0], P1, 0, 0, 0); } } while (0)
#define ATT_RESC(a) do { if (__any((a) < 1.f)) { if (hi == 0) al_l[r32] = (a); asm volatile("s_waitcnt lgkmcnt(0)" ::: "memory"); \
    _Pragma("unroll") for (int d = 0; d < 4; ++d) _Pragma("unroll") for (int r = 0; r < 16; ++r) o[d][r] *= al_l[crow(r, hi)]; } } while (0)
#define ATT_MASKW(j) (MASKED ? *(const u32x2v*)(mrow + 2 * (j)) : (u32x2v){0u, 0u})
    f32x16 p0, p1; float mn, al; bf16x8 pa0, pa1, pa2, pa3; u32x2v mk;
    constexpr int NST = 2 + KST;
    ATT_STAGE(0, 0); ATT_STAGE(64, 1);
    asm volatile("s_waitcnt vmcnt(%0) lgkmcnt(0)\n\ts_barrier" :: "n"(NST) : "memory");
    int buf = 0;
    for (int j = 0; j < NT; ++j) {
        const int b2 = buf == 0 ? 2 : buf - 1;
        mk = ATT_MASKW(j);
        if (j + 2 < NT) ATT_STAGE((j + 2) * 64, b2);
        ATT_SBAR();
        ATT_QKT(p0, p1, buf);
        partialSM<MASKED>(p0, p1, m_reg, mn, al, C, THRS, j < lim, mk, hi);
        ATT_RESC(al);
        finishSM(p0, p1, al, l_reg, pa0, pa1, pa2, pa3); ATT_SBAR();
        pv_d0(o, vb0 + buf * SHM_V, pa0, pa1, pa2, pa3);
        if (j + 2 < NT) asm volatile("s_waitcnt vmcnt(%0) lgkmcnt(0)\n\ts_barrier" :: "n"(NST) : "memory");
        else asm volatile("s_waitcnt vmcnt(0) lgkmcnt(0)\n\ts_barrier" ::: "memory");
        buf = buf == 2 ? 0 : buf + 1;
    }
    if (hi == 0) li_l[r32] = l_reg; asm volatile("s_waitcnt lgkmcnt(0)" ::: "memory");
    float rli[16];
#pragma unroll
    for (int r = 0; r < 16; ++r) rli[r] = __builtin_amdgcn_rcpf(li_l[crow(r, hi)]);
    __syncthreads();
    unsigned short* stg = (unsigned short*)(lds + wid * 8192);
#pragma unroll
    for (int r = 0; r < 16; ++r) { const int orow = crow(r, hi);
#pragma unroll
        for (int d0 = 0; d0 < 4; ++d0) stg[orow * 128 + d0 * 32 + r32] = (unsigned short)(cvtpk(o[d0][r] * rli[r], 0.f) & 0xffffu); }
    asm volatile("s_waitcnt lgkmcnt(0)" ::: "memory");
    bf16* Ow = Ob + (size_t)(wid * 32) * 4096;
#pragma unroll
    for (int i = 0; i < 8; ++i) { const int idx = lane + 64 * i, row = idx >> 4, ch = idx & 15;
        const u32x4 w = *(const u32x4*)((const char*)stg + row * 256 + ch * 16);
        *(u32x4*)(Ow + (size_t)row * 4096 + ch * 8) = w; }
    __syncthreads();
#undef ATT_STAGE
#undef ATT_QKT
#undef ATT_RESC
#undef ATT_MASKW
#undef ATT_KSWZ
}
__device__ __forceinline__ void unit_of(int it, int& bh, int& qb) { const int j = it & 255, s = it >> 8; bh = j >> 1; const int base = 2 * (j & 1) + (s >> 1); qb = (s & 1) ? 7 - base : base; }
}

__device__ __forceinline__ void phase_dsa_indexer(const bf16* QI, const bf16* KI, const float* WI, float* SC, LAS float* xl, int vcu, int G, int wave_s) {
    QI = uni(QI); KI = uni(KI); WI = uni(WI); SC = uni(SC); vcu = uni(vcu); G = uni(G); wave_s = uni(wave_s); xl = (LAS float*)(unsigned)uni((int)(unsigned)(uintptr_t)xl);
    const int tid = opaque_tid_w(wave_s), wid = wave_s, lane = tid & 63, r32 = lane & 31, hi = lane >> 5;
    const int blk = wid & 3, kb = blk & 1, qb2 = blk >> 1, hh = wid >> 2;
#define IDX_DECODE(U_, Q0_, S0_, KT_) do { const int b_ = (U_) / 528, rem_ = (U_) - b_ * 528; int c_ = (int)((sqrtf(8.0f * (float)rem_ + 1.0f) - 1.0f) * 0.5f); \
        while ((c_ + 1) * (c_ + 2) / 2 <= rem_) ++c_; while (c_ * (c_ + 1) / 2 > rem_) --c_; KT_ = rem_ - c_ * (c_ + 1) / 2; \
        Q0_ = b_ * SEQ + 64 * c_ + 32 * qb2; S0_ = b_ * SEQ + 64 * KT_ + 32 * kb; } while (0)
#define IDX_KLOAD(K_, S0_) do { _Pragma("unroll") for (int ks = 0; ks < 8; ++ks) K_[ks] = *(const bf16x8*)(KI + (size_t)((S0_) >> 5) * 4096 + ((ks * 2 + hi) * 32 + r32) * 8); } while (0)
#define IDX_QROW(Q0_) (QI + ((size_t)((Q0_) >> 5) * 32 + 16 * hh) * 4096 + (hi * 32 + r32) * 8)
#define IDX_WROW(Q0_) (WI + (size_t)((Q0_) >> 5) * 1024 + (16 * hh) * 32 + r32)
#define IDX_LOAD(Q_, W_, HD_) do { _Pragma("unroll") for (int ks = 0; ks < 8; ++ks) Q_[ks] = *(const bf16x8*)(qrow + (HD_) * 4096 + 512 * ks); W_ = wrow[(HD_) * 32]; } while (0)
#define IDX_HEAD(Q_, W_) do { f32x16 p = {}; _Pragma("unroll") for (int ks = 0; ks < 8; ++ks) p = __builtin_amdgcn_mfma_f32_32x32x16_bf16(kf[ks], Q_[ks], p, 0, 0, 0); \
        _Pragma("unroll") for (int r = 0; r < 16; ++r) sc[r] += W_ * fmaxf(p[r], 0.f); } while (0)
    const int NU = NB * 528;
    if (vcu < NU) {
        int q0, s0, kt; IDX_DECODE(vcu, q0, s0, kt);
        bf16x8 kf[8], kfn[8], qa[8], qb[8]; float wa, wb;
        IDX_KLOAD(kf, s0);
        const bf16* qrow = IDX_QROW(q0); const float* wrow = IDX_WROW(q0);
        IDX_LOAD(qa, wa, 0);
        for (int u = vcu; u < NU; u += G) {
            f32x16 sc = {};
#pragma unroll 1
            for (int hd = 0; hd < 14; hd += 2) {
                IDX_LOAD(qb, wb, hd + 1);
                IDX_HEAD(qa, wa);
                IDX_LOAD(qa, wa, hd + 2);
                IDX_HEAD(qb, wb);
            }
            IDX_LOAD(qb, wb, 15);
            IDX_HEAD(qa, wa);
            const int un = u + G < NU ? u + G : u; int q0n, s0n, ktn; IDX_DECODE(un, q0n, s0n, ktn);
            IDX_KLOAD(kfn, s0n);
            const bf16* qrow_n = IDX_QROW(q0n); const float* wrow_n = IDX_WROW(q0n);
            { const bf16* qrow_c = qrow; const float* wrow_c = wrow; qrow = qrow_n; wrow = wrow_n; IDX_LOAD(qa, wa, 0); qrow = qrow_c; wrow = wrow_c; }
            IDX_HEAD(qb, wb);
            if (hh == 1) {
#pragma unroll
                for (int g = 0; g < 4; ++g) *(LAS f32x4*)(xl + (blk * 64 + lane) * 16 + 4 * g) = (f32x4){sc[4 * g], sc[4 * g + 1], sc[4 * g + 2], sc[4 * g + 3]};
            }
            __syncthreads();
            if (hh == 0) {
                float* orow = SC + (size_t)(q0 + r32) * SEQ + 64 * kt + 32 * kb + 4 * hi;
#pragma unroll
                for (int g = 0; g < 4; ++g) { const f32x4 t = *(const LAS f32x4*)(xl + (blk * 64 + lane) * 16 + 4 * g);
                    *(f32x4*)(orow + 8 * g) = (f32x4){sc[4 * g] + t[0], sc[4 * g + 1] + t[1], sc[4 * g + 2] + t[2], sc[4 * g + 3] + t[3]}; }
            }
            __syncthreads();
#pragma unroll
            for (int ks = 0; ks < 8; ++ks) kf[ks] = kfn[ks];
            q0 = q0n; s0 = s0n; kt = ktn; qrow = qrow_n; wrow = wrow_n;
        }
    }
#undef IDX_DECODE
#undef IDX_KLOAD
#undef IDX_QROW
#undef IDX_WROW
#undef IDX_LOAD
#undef IDX_HEAD
}
__device__ __forceinline__ unsigned f2key(float f) { const unsigned u = __float_as_uint(f); return (u & 0x80000000u) ? ~u : (u | 0x80000000u); }
__device__ __forceinline__ int wave_count(int c) { int t = 0;
#pragma unroll
    for (int b = 0; b < 6; ++b) t += __builtin_popcountll(__ballot((c >> b) & 1)) << b;
    return t; }
THIN_FN void phase_dsa_topk(const float* SC, unsigned* MASK, int gw, int ngw, int lane) {
    SC = uni(SC); MASK = uni(MASK); gw = uni(gw); ngw = uni(ngw);
    for (int tq = gw; tq < MT; tq += ngw) {
        const int t = tq & (SEQ - 1), n = ((t >> 6) + 1) * 64;
        unsigned key[32];
#pragma unroll
        for (int i = 0; i < 8; ++i) { const int k0 = 256 * i + 4 * lane;
            f32x4 v = (f32x4){0.f, 0.f, 0.f, 0.f}; const bool ok = k0 < n;
            if (ok) v = *(const f32x4*)(SC + (size_t)tq * SEQ + k0);
#pragma unroll
            for (int e = 0; e < 4; ++e) key[4 * i + e] = ok ? f2key(v[e]) : 0u; }
        unsigned sel = 0u;
        if (n <= 256) {
#pragma unroll
            for (int j = 0; j < 32; ++j) sel |= (key[j] != 0u ? 1u : 0u) << j;
        } else {
            unsigned thr = 0u;
            for (int bit = 31; bit >= 0; --bit) { const unsigned cand = thr | (1u << bit); int c = 0;
#pragma unroll
                for (int j = 0; j < 32; ++j) asm volatile("v_cmp_le_u32 vcc, %1, %2\n\tv_addc_co_u32 %0, vcc, 0, %0, vcc" : "+v"(c) : "s"(cand), "v"(key[j]) : "vcc");
                if (wave_count(c) >= 256) thr = cand; }
            int cg = 0, ce = 0;
#pragma unroll
            for (int j = 0; j < 32; ++j) { asm volatile("v_cmp_lt_u32 vcc, %1, %2\n\tv_addc_co_u32 %0, vcc, 0, %0, vcc" : "+v"(cg) : "s"(thr), "v"(key[j]) : "vcc");
                                           asm volatile("v_cmp_eq_u32 vcc, %1, %2\n\tv_addc_co_u32 %0, vcc, 0, %0, vcc" : "+v"(ce) : "s"(thr), "v"(key[j]) : "vcc"); }
            const int gt = wave_count(cg), eq = wave_count(ce);
            const int need = 256 - gt;
            if (eq == need) {
#pragma unroll
                for (int j = 0; j < 32; ++j) sel |= (key[j] >= thr ? 1u : 0u) << j;
            } else {
                int run = 0; const unsigned long long lt = (1ull << lane) - 1ull;
#pragma unroll
                for (int i = 0; i < 8; ++i) { int below = 0, mine = 0, tot = 0;
#pragma unroll
                    for (int e = 0; e < 4; ++e) { const unsigned long long bm = __ballot(key[4 * i + e] == thr); below += __builtin_popcountll(bm & lt); tot += __builtin_popcountll(bm); }
#pragma unroll
                    for (int e = 0; e < 4; ++e) { const bool iseq = key[4 * i + e] == thr; const int rank = run + below + mine;
                        const bool take = key[4 * i + e] > thr || (iseq && rank < need);
                        sel |= (take ? 1u : 0u) << (4 * i + e); mine += iseq ? 1 : 0; }
                    run += tot; }
            }
        }
#pragma unroll
        for (int i = 0; i < 8; ++i) { unsigned w = ((sel >> (4 * i)) & 15u) << (4 * (lane & 7));
            w |= __shfl_xor(w, 1); w |= __shfl_xor(w, 2); w |= __shfl_xor(w, 4);
            if ((lane & 7) == 0) MASK[(size_t)tq * 64 + 8 * i + (lane >> 3)] = w; }
    }
}
#define CAS_ __attribute__((address_space(4)))
typedef const GAS float* gfp_t;
__device__ __forceinline__ gfp_t karg_in(int k) { return (gfp_t)((const CAS_ unsigned long long*)__builtin_amdgcn_kernarg_segment_ptr())[k]; }
struct BgTile { gfp_t W; int gi, goff; int Ksrc, N, k0, n0; DstAny dst; };
constexpr int BG_T_GU = 64 * 192, BG_T_DN = 96 * 64, BG_T_FFN = BG_T_GU + BG_T_DN, BG_T_MIN = 64 * 25, BG_T_UQ = 16 * 96, BG_T_UKV = 8 * 128, BG_T_WO = 64 * 64,
              BG_T_MLA = BG_T_MIN + BG_T_UQ + BG_T_UKV + BG_T_WO, BG_TOTAL = 3 * BG_T_FFN + BG_T_MLA;
__device__ __forceinline__ BgTile bg_decode(int t, unsigned char* ws) {
    BgTile d; int r, nnb;
    const bool isffn = t < 2 * BG_T_FFN || t >= 2 * BG_T_FFN + BG_T_MLA;
    if (isffn) { const int f = t < BG_T_FFN ? 0 : (t < 2 * BG_T_FFN ? 1 : 2); r = t - (f == 2 ? 2 * BG_T_FFN + BG_T_MLA : f * BG_T_FFN);
        const int i = 5 + f, L = i >> 1, j = i & 1, fb = L == 2 ? 18 : 40; unsigned char* wf = ws + WS_WFFN + (size_t)i * SZ_FFN;
        if (r < BG_T_GU) { d.W = karg_in(fb + 1) + (size_t)j * DM * 2 * DFF; d.gi = fb; d.goff = j * DM; d.Ksrc = DM; d.N = 2 * DFF; nnb = 192; d.dst = DstAny{1, (bf16*)wf, nullptr, DM, 2 * DFF}; }
        else { r -= BG_T_GU; d.W = karg_in(fb + 2) + (size_t)j * DFF * DM; d.gi = -1; d.goff = 0; d.Ksrc = DFF; d.N = DM; nnb = 64; d.dst = DstAny{0, (bf16*)(wf + SZ_WGU), nullptr, DFF, DM}; }
    } else { r = t - 2 * BG_T_FFN; unsigned char* wb = ws + WS_WMLA + SZ_MLA;
        if (r < BG_T_MIN) { d.W = karg_in(44); d.gi = 43; d.goff = 0; d.Ksrc = DM; d.N = 1600; nnb = 25; d.dst = DstAny{0, (bf16*)wb, nullptr, DM, 1600}; }
        else if (r < BG_T_MIN + BG_T_UQ) { r -= BG_T_MIN; d.W = karg_in(46); d.gi = 45; d.goff = 0; d.Ksrc = 1024; d.N = 6144; nnb = 96; d.dst = DstAny{2, (bf16*)(wb + SZ_MLA_IN), nullptr, 1024, 6144}; }
        else if (r < BG_T_MIN + BG_T_UQ + BG_T_UKV) { r -= BG_T_MIN + BG_T_UQ; d.W = karg_in(48); d.gi = 47; d.goff = 0; d.Ksrc = 512; d.N = 8192; nnb = 128; d.dst = DstAny{0, (bf16*)(wb + SZ_MLA_IN + SZ_MLA_UQ), nullptr, 512, 8192}; }
        else { r -= BG_T_MIN + BG_T_UQ + BG_T_UKV; d.W = karg_in(49); d.gi = -1; d.goff = 0; d.Ksrc = DM; d.N = DM; nnb = 64; d.dst = DstAny{0, (bf16*)(wb + SZ_MLA_IN + SZ_MLA_UQ + SZ_MLA_UKV), nullptr, DM, DM}; } }
    const int kb = r / nnb; d.k0 = kb * 64; d.n0 = (r - kb * nnb) * 64; return d;
}
__device__ __forceinline__ void bg_issue(const BgTile& d, f32x4 (&v)[16], f32x2v (&g)[8], int lane) {
    const int kr = lane >> 4, nc0 = (lane & 15) * 4, nc = d.n0 + nc0 <= d.N - 4 ? nc0 : d.N - 4 - d.n0;
    const GAS char* wb = (const GAS char*)(d.W + (size_t)d.k0 * d.N + d.n0);
    const unsigned rowb = (unsigned)d.N * 4u, off0 = (unsigned)(2 * kr) * rowb + (unsigned)nc * 4u;
#pragma unroll
    for (int i = 0; i < 8; ++i)
#pragma unroll
        for (int e = 0; e < 2; ++e) v[2 * i + e] = __builtin_nontemporal_load((const GAS f32x4*)(wb + (off0 + (unsigned)(8 * i + e) * rowb)));
    { const bool hg = d.gi >= 0; const GAS char* gb = (const GAS char*)(karg_in(hg ? d.gi : 0) + (hg ? d.goff : 0) + d.k0); const unsigned go = (unsigned)(2 * kr) * 4u;
#pragma unroll
        for (int i = 0; i < 8; ++i) g[i] = *(const GAS f32x2v*)(gb + (go + 32u * i)); }
}
__device__ __forceinline__ void bg_finish(const BgTile& d, bf16* dstp, int ld, const f32x4 (&v)[16], const f32x2v (&g)[8], LAS unsigned* scr, int lane) {
    const int kr = lane >> 4, nc = (lane & 15) * 4;
    LAS unsigned* sw = scr + nc * 33 + kr;
    const bool hg = d.gi >= 0;
#pragma unroll
    for (int i = 0; i < 8; ++i) { const f32x4 a = v[2 * i] * (hg ? g[i][0] : 1.0f), b = v[2 * i + 1] * (hg ? g[i][1] : 1.0f);
#pragma unroll
        for (int e = 0; e < 4; ++e) sw[e * 33 + 4 * i] = cvtpk(a[e], b[e]); }
    LDS_WAIT(); asm volatile("" ::: "memory");
    const int c = lane & 7, nl0 = lane >> 3; const LAS unsigned* sr = scr + nl0 * 33 + 4 * c;
#pragma unroll
    for (int j = 0; j < 8; ++j) { const LAS unsigned* s = sr + j * (8 * 33);
        const v4u o = (v4u){s[0], s[1], s[2], s[3]};
        if (dstp && d.dst.mode < 2 && !(d.N == 1600 && d.n0 == 1536)) *(GAS v4u*)((GAS char*)dstp + ((unsigned)(nl0 + 8 * j) * (unsigned)ld + 8u * c) * 2u) = o;
        else { bf16* dp = d.dst(d.n0 + nl0 + 8 * j, d.k0); if (dp) *(v4u*)(dp + d.k0 + 8 * c) = o; } }
    LDS_WAIT(); asm volatile("" ::: "memory");
}
__device__ __forceinline__ BgTile ffn_decode(int i, int r, unsigned char* ws) {
    BgTile d; int nnb; const int L = i >> 1, j = i & 1, fb = L == 0 ? 2 : (L == 1 ? 12 : (L == 2 ? 18 : 40)); unsigned char* wf = ws + WS_WFFN + (size_t)i * SZ_FFN;
    if (r < BG_T_GU) { d.W = karg_in(fb + 1) + (size_t)j * DM * 2 * DFF; d.gi = fb; d.goff = j * DM; d.Ksrc = DM; d.N = 2 * DFF; nnb = 192; d.dst = DstAny{1, (bf16*)wf, nullptr, DM, 2 * DFF}; }
    else { r -= BG_T_GU; d.W = karg_in(fb + 2) + (size_t)j * DFF * DM; d.gi = -1; d.goff = 0; d.Ksrc = DFF; d.N = DM; nnb = 64; d.dst = DstAny{0, (bf16*)(wf + SZ_WGU), nullptr, DFF, DM}; }
    const int kb = r / nnb; d.k0 = kb * 64; d.n0 = (r - kb * nnb) * 64; return d;
}
constexpr int MX_T_DSA_IN = 64 * 163, MX_T_SQ = 64 * 64;
__device__ __forceinline__ BgTile mix_decode(int L, int t, unsigned char* ws) {
    BgTile d; int r = t, nnb; d.goff = 0;
    if (L == 0) { unsigned char* wb = ws + WS_WMLA;
        if (r < BG_T_MIN) { d.W = karg_in(6); d.gi = 5; d.Ksrc = DM; d.N = 1600; nnb = 25; d.dst = DstAny{0, (bf16*)wb, nullptr, DM, 1600}; }
        else if (r < BG_T_MIN + BG_T_UQ) { r -= BG_T_MIN; d.W = karg_in(8); d.gi = 7; d.Ksrc = 1024; d.N = 6144; nnb = 96; d.dst = DstAny{2, (bf16*)(wb + SZ_MLA_IN), nullptr, 1024, 6144}; }
        else if (r < BG_T_MIN + BG_T_UQ + BG_T_UKV) { r -= BG_T_MIN + BG_T_UQ; d.W = karg_in(10); d.gi = 9; d.Ksrc = 512; d.N = 8192; nnb = 128; d.dst = DstAny{0, (bf16*)(wb + SZ_MLA_IN + SZ_MLA_UQ), nullptr, 512, 8192}; }
        else { r -= BG_T_MIN + BG_T_UQ + BG_T_UKV; d.W = karg_in(11); d.gi = -1; d.Ksrc = DM; d.N = DM; nnb = 64; d.dst = DstAny{0, (bf16*)(wb + SZ_MLA_IN + SZ_MLA_UQ + SZ_MLA_UKV), nullptr, DM, DM}; }
    } else if (L == 1) { unsigned char* wb = ws + WS_WDSA;
        if (r < MX_T_DSA_IN) { d.W = karg_in(16); d.gi = 15; d.Ksrc = DM; d.N = 10400; nnb = 163; d.dst = DstAny{3, (bf16*)wb, (bf16*)(wb + SZ_DSA_IN), DM, 10400}; }
        else { r -= MX_T_DSA_IN; d.W = karg_in(17); d.gi = -1; d.Ksrc = DM; d.N = DM; nnb = 64; d.dst = DstAny{0, (bf16*)(wb + SZ_DSA_IN + SZ_DSA_NAR), nullptr, DM, DM}; }
    } else { const int k = r >> 12; r &= 4095; d.W = karg_in(23 + k); d.gi = -1; d.Ksrc = DM; d.N = DM; nnb = 64; d.dst = DstAny{0, (bf16*)(ws + WS_WRW + (size_t)k * SZ_SQ), nullptr, DM, DM}; }
    const int kb = r / nnb; d.k0 = kb * 64; d.n0 = (r - kb * nnb) * 64; return d;
}
template <bool FFN>
__device__ __forceinline__ void cvt_list_pipelined(int i, unsigned char* ws, int gw, int ngw, LAS unsigned* scr, int lane) {
    const int cnt = FFN ? BG_T_FFN : (i == 0 ? BG_T_MLA : (i == 1 ? MX_T_DSA_IN + MX_T_SQ : 4 * MX_T_SQ));
#define CL_DEC(T_) (FFN ? ffn_decode(i, (T_), ws) : mix_decode(i, (T_), ws))
#define CL_FIN(D_, V_, G_) bg_finish(D_, D_.dst(D_.n0) + D_.k0, D_.dst.ld, V_, G_, scr, lane)
    f32x4 va[16], vb[16]; f32x2v ga[8], gb[8];
    int t = gw; if (t >= cnt) return;
    { const BgTile d = CL_DEC(t); bg_issue(d, va, ga, lane); }
    while (true) {
        const int t2 = t + ngw; { const BgTile d = CL_DEC(t2 < cnt ? t2 : t); bg_issue(d, vb, gb, lane); }
        { const BgTile d = CL_DEC(t); CL_FIN(d, va, ga); }
        if (t2 >= cnt) break;
        const int t3 = t2 + ngw; { const BgTile d = CL_DEC(t3 < cnt ? t3 : t2); bg_issue(d, va, ga, lane); }
        { const BgTile d = CL_DEC(t2); CL_FIN(d, vb, gb); }
        if (t3 >= cnt) break;
        t = t3;
    }
#undef CL_DEC
#undef CL_FIN
}
__device__ __forceinline__ void phase_rwkv_scan(const unsigned char* scr, unsigned char* ws, const float* k_k, const float* k_a, const float* r_k, const float* lnx_w, const float* lnx_b, bf16* YG, LAS float* ldsf, int vcu, int G, int wave_s) {
    constexpr int TC = 16, NCH = SEQ / TC, STEPF = 6 * 64, CHF = TC * STEPF;
    const int tid = opaque_tid_w(wave_s), w = wave_s, lane = tid & 63;
    LAS float* stage = ldsf;
    LAS float* ybuf = ldsf + 3 * CHF;
    LAS float* bonb = ybuf + 2 * TC * 64;
    LAS unsigned* bgs = (LAS unsigned*)(ldsf + 3 * CHF + 2 * TC * 64 + 64) + w * (64 * 33);
    static_assert((3 * CHF + 2 * TC * 64 + 64 + NWAVES * 64 * 33) * 4 <= LDSCTL_OFF, "scan LDS map");
    const unsigned short* const GG = (const unsigned short*)(scr + RW_G);
    const bool rec = w < 4, bgw = w >= 6; const int hw = w & 3, sh = w & 1;
    const int bg_gw = vcu * 2 + sh, bg_ngw = G * 2; int bg_n = 0;
    const int t2 = sh * 64 + lane, stl = t2 >> 4, c4 = t2 & 15;
    const size_t goffs = ((size_t)stl * DM + 4 * c4) * 4; const int lo0 = stl * STEPF + 4 * c4;
    const int rp = lane >> 3, kq = lane & 7, row = 16 * hw + 2 * rp;
    if (rec) __builtin_amdgcn_s_setprio(2);
    for (int bh = vcu; bh < NB * 64; bh += G) {
        const int b = bh >> 6, h = bh & 63;
        const size_t base0 = (size_t)b * SEQ * DM + h * 64;
        const unsigned char* gb = scr + base0 * 4 + goffs;
        const f32x4 kk4 = *(const f32x4*)(k_k + h * 64 + 4 * c4), ka4 = *(const f32x4*)(k_a + h * 64 + 4 * c4), rk4 = *(const f32x4*)(r_k + h * 64 + 4 * c4);
        f32x2v S0[4], S1[4];
#pragma unroll
        for (int i = 0; i < 4; ++i) { S0[i] = (f32x2v){0.f, 0.f}; S1[i] = (f32x2v){0.f, 0.f}; }
        const float lw = lnx_w[h * 64 + lane], lb = lnx_b[h * 64 + lane];
        f32x4 pre[2][5];
#define RW_LOAD(CH) do { _Pragma("unroll") for (int j_ = 0; j_ < 2; ++j_) { const size_t co_ = ((size_t)(CH) * TC + 8 * j_) * DM * 4; \
                         pre[j_][0] = *(const f32x4*)(gb + RW_K + co_); pre[j_][1] = *(const f32x4*)(gb + RW_AA + co_); pre[j_][2] = *(const f32x4*)(gb + RW_R + co_); \
                         pre[j_][3] = *(const f32x4*)(gb + RW_DEC + co_); pre[j_][4] = *(const f32x4*)(gb + RW_V + co_); } } while (0)
#define RW_PUT(CB) do { _Pragma("unroll") for (int j_ = 0; j_ < 2; ++j_) { LAS float* sb_ = stage + (CB) * CHF + lo0 + 8 * j_ * STEPF; const f32x4 kr = pre[j_][0] * kk4; \
            const float ss = row_sum16((kr[0] * kr[0] + kr[1] * kr[1]) + (kr[2] * kr[2] + kr[3] * kr[3])); const f32x4 kkv = kr * (1.0f / fmaxf(sqrtf(ss), 1e-12f)); \
            const f32x4 kp = pre[j_][0] * ((pre[j_][1] - 1.0f) * ka4 + 1.0f); const f32x4 rkp = pre[j_][2] * kp * rk4; const float bon = row_sum16((rkp[0] + rkp[1]) + (rkp[2] + rkp[3])); \
            *(LAS f32x4*)(sb_) = -kkv; *(LAS f32x4*)(sb_ + 128) = kkv * pre[j_][1]; *(LAS f32x4*)(sb_ + 192) = kp; *(LAS f32x4*)(sb_ + 256) = pre[j_][2]; if (c4 == 0) bonb[(CB) * TC + stl + 8 * j_] = bon; \
            *(LAS f32x4*)(sb_ + 64) = pre[j_][3]; *(LAS f32x4*)(sb_ + 320) = pre[j_][4]; } } while (0)
        const int ps2 = lane >> 3, pg = lane & 7, ptl = 8 * sh + ps2;
        const f32x4 lw0 = *(const f32x4*)(lnx_w + h * 64 + 8 * pg), lw1 = *(const f32x4*)(lnx_w + h * 64 + 8 * pg + 4), lb0 = *(const f32x4*)(lnx_b + h * 64 + 8 * pg), lb1 = *(const f32x4*)(lnx_b + h * 64 + 8 * pg + 4);
        u32x4 gq = {0u, 0u, 0u, 0u};
#define RW_GLOAD(CC) do { gq = *(const u32x4*)(GG + base0 + (size_t)((CC) * TC + ptl) * DM + 8 * pg); } while (0)
#define RW_POST(CC, ST_) do { const int cc_ = (CC), cbp_ = cc_ & 1, sbp_ = cc_ % 3; const size_t idx = base0 + (size_t)(cc_ * TC + ptl) * DM + 8 * pg; \
            const LAS float* yp_ = ybuf + (cbp_ * TC + ptl) * 64 + 8 * pg; const f32x4 y0 = *(const LAS f32x4*)(yp_), y1 = *(const LAS f32x4*)(yp_ + 4); \
            float sm = ((y0[0] + y0[1]) + (y0[2] + y0[3])) + ((y1[0] + y1[1]) + (y1[2] + y1[3])); \
            sm += WS_DPP(sm, 0xB1); sm += WS_DPP(sm, 0x4E); sm += WS_DPP(sm, 0x141); \
            const float mean = sm * (1.0f / 64.0f); const f32x4 d0 = y0 - mean, d1 = y1 - mean; \
            float sq = ((d0[0] * d0[0] + d0[1] * d0[1]) + (d0[2] * d0[2] + d0[3] * d0[3])) + ((d1[0] * d1[0] + d1[1] * d1[1]) + (d1[2] * d1[2] + d1[3] * d1[3])); \
            sq += WS_DPP(sq, 0xB1); sq += WS_DPP(sq, 0x4E); sq += WS_DPP(sq, 0x141); \
            const float rstd = __builtin_amdgcn_rsqf(sq * (1.0f / 64.0f) + 64e-5f), bon = bonb[sbp_ * TC + ptl]; \
            const LAS float* vp_ = stage + sbp_ * CHF + ptl * STEPF + 320 + 8 * pg; const f32x4 v0 = *(const LAS f32x4*)(vp_), v1 = *(const LAS f32x4*)(vp_ + 4); \
            const f32x4 o0 = (d0 * rstd * lw0 + lb0 + v0 * bon) * bf_lo4(gq, 0), o1 = (d1 * rstd * lw1 + lb1 + v1 * bon) * bf_lo4(gq, 1); \
            if (ST_) *(u32x4*)((unsigned short*)YG + idx) = pack8(o0, o1); } while (0)
        if (rec) {
            __syncthreads();
            int sbuf = 0;
            for (int c = 0; c < NCH; ++c) {
                const int cb = c & 1, sb = sbuf; sbuf = sbuf == 2 ? 0 : sbuf + 1;
                const LAS float* st = stage + sb * CHF + 8 * kq; const LAS float* sv = stage + sb * CHF + 320 + row; LAS float* yb = ybuf + cb * TC * 64 + row;
                f32x4 na[2], wd[2], bb[2], kp[2], rr[2];
#pragma unroll
                for (int q = 0; q < 2; ++q) { na[q] = *(const LAS f32x4*)(st + 4 * q); wd[q] = *(const LAS f32x4*)(st + 64 + 4 * q); bb[q] = *(const LAS f32x4*)(st + 128 + 4 * q); kp[q] = *(const LAS f32x4*)(st + 192 + 4 * q); rr[q] = *(const LAS f32x4*)(st + 256 + 4 * q); }
                f32x2v vv = *(const LAS f32x2v*)(sv);
#define RW_PR(v_, i_) ((f32x2v){v_[(i_) >> 1][2 * ((i_) & 1)], v_[(i_) >> 1][2 * ((i_) & 1) + 1]})
                float yq0 = 0.f, yq1 = 0.f;
#pragma unroll
                for (int tl = 0; tl < TC; ++tl) {
                    f32x4 na2[2], wd2[2], bb2[2], kp2[2], rr2[2]; f32x2v vv2 = vv;
#pragma unroll
                    for (int q = 0; q < 2; ++q) { na2[q] = na[q]; wd2[q] = wd[q]; bb2[q] = bb[q]; kp2[q] = kp[q]; rr2[q] = rr[q]; }
                    if (tl + 1 < TC) { const LAS float* sp = st + (tl + 1) * STEPF;
#pragma unroll
                        for (int q = 0; q < 2; ++q) { na2[q] = *(const LAS f32x4*)(sp + 4 * q); wd2[q] = *(const LAS f32x4*)(sp + 64 + 4 * q); bb2[q] = *(const LAS f32x4*)(sp + 128 + 4 * q); kp2[q] = *(const LAS f32x4*)(sp + 192 + 4 * q); rr2[q] = *(const LAS f32x4*)(sp + 256 + 4 * q); }
                        vv2 = *(const LAS f32x2v*)(sv + (tl + 1) * STEPF); }
                    __builtin_amdgcn_sched_barrier(0);
                    f32x2v p0 = S0[0] * RW_PR(na, 0), p1 = S1[0] * RW_PR(na, 0);
#pragma unroll
                    for (int i = 1; i < 4; ++i) { p0 = S0[i] * RW_PR(na, i) + p0; p1 = S1[i] * RW_PR(na, i) + p1; }
                    float sa0 = p0[0] + p0[1], sa1 = p1[0] + p1[1];
                    sa0 += WS_DPP(sa0, 0xB1); sa1 += WS_DPP(sa1, 0xB1); yq0 += WS_DPP(yq0, 0xB1); yq1 += WS_DPP(yq1, 0xB1);
                    sa0 += WS_DPP(sa0, 0x4E); sa1 += WS_DPP(sa1, 0x4E); yq0 += WS_DPP(yq0, 0x4E); yq1 += WS_DPP(yq1, 0x4E);
                    sa0 += WS_DPP(sa0, 0x141); sa1 += WS_DPP(sa1, 0x141); yq0 += WS_DPP(yq0, 0x141); yq1 += WS_DPP(yq1, 0x141);
                    asm("" : "+v"(yq0), "+v"(yq1));
                    if (tl > 0) *(LAS f32x2v*)(yb + (tl - 1) * 64) = (f32x2v){yq0, yq1};
                    const f32x2v s0 = {sa0, sa0}, s1 = {sa1, sa1}, v0 = {vv[0], vv[0]}, v1 = {vv[1], vv[1]};
#pragma unroll
                    for (int i = 0; i < 4; ++i) { S0[i] = S0[i] * RW_PR(wd, i) + (RW_PR(bb, i) * s0 + RW_PR(kp, i) * v0); S1[i] = S1[i] * RW_PR(wd, i) + (RW_PR(bb, i) * s1 + RW_PR(kp, i) * v1); }
                    f32x2v q0 = S0[0] * RW_PR(rr, 0), q1 = S1[0] * RW_PR(rr, 0);
#pragma unroll
                    for (int i = 1; i < 4; ++i) { q0 = S0[i] * RW_PR(rr, i) + q0; q1 = S1[i] * RW_PR(rr, i) + q1; }
                    yq0 = q0[0] + q0[1]; yq1 = q1[0] + q1[1];
#pragma unroll
                    for (int q = 0; q < 2; ++q) { na[q] = na2[q]; wd[q] = wd2[q]; bb[q] = bb2[q]; kp[q] = kp2[q]; rr[q] = rr2[q]; }
                    vv = vv2;
                }
                yq0 += WS_DPP(yq0, 0xB1); yq1 += WS_DPP(yq1, 0xB1); yq0 += WS_DPP(yq0, 0x4E); yq1 += WS_DPP(yq1, 0x4E); yq0 += WS_DPP(yq0, 0x141); yq1 += WS_DPP(yq1, 0x141);
                asm("" : "+v"(yq0), "+v"(yq1));
                *(LAS f32x2v*)(yb + (TC - 1) * 64) = (f32x2v){yq0, yq1};
#undef RW_PR
                __syncthreads();
            }
            __syncthreads();
        } else if (bgw) {
            f32x4 va[16]; f32x2v ga[8];
#define BG_T(N_) ((bg_gw + (N_) * bg_ngw) < BG_TOTAL ? (bg_gw + (N_) * bg_ngw) : BG_TOTAL - 1)
            int tA = BG_T(bg_n);
            { const BgTile d = bg_decode(tA, ws); bg_issue(d, va, ga, lane); }
            __syncthreads();
            for (int c = 0; c < NCH; ++c) {
                { const BgTile d = bg_decode(tA, ws); bg_finish(d, d.dst(d.n0) + d.k0, d.dst.ld, va, ga, bgs, lane); }
                tA = BG_T(bg_n + c + 1); { const BgTile d = bg_decode(tA, ws); bg_issue(d, va, ga, lane); }
                __syncthreads();
            }
            { const BgTile d = bg_decode(tA, ws); bg_finish(d, d.dst(d.n0) + d.k0, d.dst.ld, va, ga, bgs, lane); }
            bg_n += NCH + 1;
#undef BG_T
            __syncthreads();
        } else {
            RW_LOAD(0); RW_PUT(0); RW_LOAD(1); RW_GLOAD(0);
            __syncthreads();
            int sbuf = 0;
            for (int c = 0; c < NCH; ++c) {
                const int sn = sbuf == 2 ? 0 : sbuf + 1; sbuf = sn;
                RW_POST(c > 0 ? c - 1 : 0, c > 0);
                RW_PUT(sn);
                RW_LOAD(c + 2 < NCH ? c + 2 : NCH - 1);
                RW_GLOAD(c);
                __syncthreads();
            }
            RW_POST(NCH - 1, true);
            __syncthreads();
        }
#undef RW_LOAD
#undef RW_PUT
#undef RW_POST
#undef RW_GLOAD
    }
    __builtin_amdgcn_s_setprio(0);
    if (bgw) { f32x4 bgv[16]; f32x2v bgg[8];
        for (int t = bg_gw + bg_n * bg_ngw; t < BG_TOTAL; t += bg_ngw) { const BgTile d = bg_decode(t, ws); bg_issue(d, bgv, bgg, lane); bg_finish(d, nullptr, 0, bgv, bgg, bgs, lane); }
    }
}

#ifndef MK_SPLIT
#define MK_SPLIT 0
#endif
constexpr int N_PHASES = 1 + 8 * 2 + 2 * 6 + 7 + 6 + 1;
struct Args { const void* in[51]; float* out; unsigned char* ws; int ph_lo, ph_hi; };
static_assert(sizeof(Args) == 51 * 8 + 8 + 8 + 8, "Args has no padding");

template <unsigned PMASK> __global__ void __launch_bounds__(NTHR, 2) mega_fwd(Args args) {
    extern __shared__ __attribute__((aligned(16))) unsigned char lds[];
    LAS unsigned char* ldsl = (LAS unsigned char*)lds;
    const int G = gridDim.x, bx = blockIdx.x, vcu = (G % 8 == 0) ? (bx % 8) * (G / 8) + bx / 8 : bx;
    const int ngw = G * NWAVES, gthreads = G * NTHR, wave_s = __builtin_amdgcn_readfirstlane(threadIdx.x >> 6);
    for (int u = threadIdx.x; u < (LDS_BYTES - LDSCTL_OFF) / 4; u += NTHR) ((LAS unsigned*)(ldsl + LDSCTL_OFF))[u] = 0u;
    __syncthreads();
    XcdBarrier bar; bar.bar = (unsigned*)(args.ws + WS_CTL) + CW_BAR; bar.x = 0; bar.st = nullptr;
    if (!MK_SPLIT) bar = xcd_barrier_post((unsigned*)(args.ws + WS_CTL) + CW_BAR, (volatile LAS unsigned*)(ldsl + LDSCTL_OFF) + 8);
    const int lo = args.ph_lo, hi = args.ph_hi; int ph = 0;
    int ni = 0;
#ifndef DUP_MASK
#define DUP_MASK 0u
#endif
#define PB(b) if constexpr (((PMASK) >> (b)) & 1u) for (int rep_ = 0; rep_ < ((((DUP_MASK) >> (b)) & 1u) ? 2 : 1); ++rep_, (rep_ < 2 && (((DUP_MASK) >> (b)) & 1u)) ? __syncthreads() : (void)0)
#define PH_ON() (ph >= lo && ph < hi)
#define PH_END() do { if (!MK_SPLIT && ph >= lo && ph + 1 < hi) { XcdBarrier b_ = bar; asm volatile("" : "+s"(b_.bar), "+s"(b_.x)); xcd_barrier(b_); } ++ph; } while (0)
#define PH_VARS const int tid = opaque_tid_w(wave_s), lane = tid & 63, wave = wave_s, gw = vcu * NWAVES + wave, gtid = vcu * NTHR + tid; \
    int zo; asm volatile("s_mov_b32 %0, 0" : "=s"(zo)); unsigned char* const ws = args.ws + zo; unsigned char* const scr = ws + WS_SCR; \
    bf16* const XH = (bf16*)(ws + WS_XH); bf16* const XL = (bf16*)(ws + WS_XL); unsigned long long* const rsqc = (unsigned long long*)(ws + CTL_RSQ) + (size_t)ni * MT; bf16* const OB = (bf16*)(ws + WS_OB); const f32x2v* const T64 = (const f32x2v*)(ws + WS_T64); const f32x2v* const T128 = (const f32x2v*)(ws + WS_T128); \
    (void)lane; (void)gw; (void)gtid; (void)scr; (void)XH; (void)XL; (void)rsqc; (void)OB; (void)T64; (void)T128;
#define INF(k) ((const float*)args.in[(k) + zo])
#define PH_END_NOBAR() do { ++ph; } while (0)
#define RUN_GEMM(EPI_T, EPI_OBJ, A_, B_, N_, K_) do { pg8::Gemm g_{(const pg8::bf16_t*)(A_), (const pg8::bf16_t*)(B_), MT, (N_), (K_)}; pg8::StaticOrder S_; S_.init(MT, (N_), G, bx); \
        pg8::gemm_phase<EPI_T, pg8::StaticOrder, true, true>(ldsl, g_, S_, (EPI_OBJ), wave_s); } while (0)
#define RUN_GEMM_SK(EPI_T, EPI_OBJ, A_, B_, N_, K_) do { pg8::Gemm g_{(const pg8::bf16_t*)(A_), (const pg8::bf16_t*)(B_), MT, (N_), (K_)}; pg8::StaticOrder S_; S_.init(MT, (N_), G, bx); \
        pg8::gemm_phase<EPI_T, pg8::StaticOrder, false, true>(ldsl, g_, S_, (EPI_OBJ), wave_s); } while (0)

#define CVT_BEGIN LAS float* cs = (LAS float*)(ldsl + wave * CVT_WAVE_BYTES); int rot = 0;
#define CVT(W_, G_, KS_, KD_, N_, MODE_, BASE_, BASE2_, LD_) rot = cvt_matrix_any((W_), (G_), (KS_), (KD_), (N_), (MODE_), (bf16*)(BASE_), (bf16*)(BASE2_), (LD_), gw, ngw, rot, cs, lane)
#define CVT_FFN(I_) do { const int L_ = (I_) >> 1, j_ = (I_) & 1, fb_ = L_ == 0 ? 2 : (L_ == 1 ? 12 : (L_ == 2 ? 18 : 40)); unsigned char* wf = ws + WS_WFFN + (size_t)(I_) * SZ_FFN; \
        CVT(INF(fb_ + 1) + (size_t)j_ * DM * 2 * DFF, INF(fb_) + j_ * DM, DM, DM, 2 * DFF, 1, wf, nullptr, DM); \
        CVT(INF(fb_ + 2) + (size_t)j_ * DFF * DM, nullptr, DFF, DFF, DM, 0, wf + SZ_WGU, nullptr, DFF); } while (0)
#define CVT_MLA(M_) do { const int mb = (M_) ? 44 : 6; unsigned char* wb = ws + WS_WMLA + (size_t)(M_) * SZ_MLA; \
        CVT(INF(mb + 0), INF(mb - 1), DM, DM, 1600, 0, wb, nullptr, DM); \
        zero_bytes(wb + (size_t)1600 * DM * 2, 192u * DM * 2, gtid, gthreads); \
        CVT(INF(mb + 2), INF(mb + 1), 1024, 1024, 6144, 2, wb + SZ_MLA_IN, nullptr, 1024); \
        CVT(INF(mb + 4), INF(mb + 3), 512, 512, 8192, 0, wb + SZ_MLA_IN + SZ_MLA_UQ, nullptr, 512); \
        CVT(INF(mb + 5), nullptr, DM, DM, DM, 0, wb + SZ_MLA_IN + SZ_MLA_UQ + SZ_MLA_UKV, nullptr, DM); } while (0)
#define CVT_DSA_SMALL() do { unsigned char* wb = ws + WS_WDSA; \
        for (int ks_ = 0; ks_ < 8; ++ks_) zero_bytes(wb + SZ_DSA_IN + ((size_t)ks_ * 256 + 160) * 512 * 2, 96u * 512 * 2, gtid, gthreads); } while (0)
#define CVT_RWKV_SMALL() do { unsigned char* wb = ws + WS_WRW; \
        CVT(INF(28), nullptr, DM, DM, 128, 0, wb + RW_W1, nullptr, DM); zero_bytes(wb + RW_W1 + (size_t)128 * DM * 2, 128u * DM * 2, gtid, gthreads); \
        CVT(INF(31), nullptr, DM, DM, 128, 0, wb + RW_A1, nullptr, DM); zero_bytes(wb + RW_A1 + (size_t)128 * DM * 2, 128u * DM * 2, gtid, gthreads); \
        CVT(INF(33), nullptr, DM, DM, 480, 0, wb + RW_G1, nullptr, DM); zero_bytes(wb + RW_G1 + (size_t)480 * DM * 2, 32u * DM * 2, gtid, gthreads); \
        CVT(INF(29), nullptr, 128, 256, DM, 0, wb + RW_W2, nullptr, 256); \
        CVT(INF(32), nullptr, 128, 256, DM, 0, wb + RW_A2, nullptr, 256); \
        CVT(INF(34), nullptr, 480, 512, DM, 0, wb + RW_G2, nullptr, 512); } while (0)
    if (PH_ON()) PB(0) { PH_VARS CVT_BEGIN
        rope_tables((const int*)args.in[1 + zo], (f32x2v*)(ws + WS_T64), (f32x2v*)(ws + WS_T128), gtid, gthreads);
        phase_split_x(INF(0), XH, XL, rsqc, gw, ngw, lane);
        cvt_list_pipelined<true>(0, ws, gw, ngw, (LAS unsigned*)(ldsl + wave * CVT_WAVE_BYTES), lane);
    }
    PH_END();

    for (int i = 0; i < 8; ++i) {
        const int L = i >> 1, j = i & 1, fb = L == 0 ? 2 : (L == 1 ? 12 : (L == 2 ? 18 : 40));
        if (PH_ON()) PB(2) { PH_VARS EpiSwiglu E{(pg8::bf16_t*)(scr + SC_ACT), rsqc}; RUN_GEMM(EpiSwiglu, E, XH, ws + WS_WFFN + (size_t)i * SZ_FFN, 2 * DFF, DM); }
        PH_END();
        if (PH_ON()) PB(3) { PH_VARS EpiResid E{(pg8::bf16_t*)XH, (pg8::bf16_t*)XL, rsqc + MT, rep_ ? 0.0f : 0.5f}; RUN_GEMM(EpiResid, E, scr + SC_ACT, ws + WS_WFFN + (size_t)i * SZ_FFN + SZ_WGU, DM, DFF);
            CVT_BEGIN
            if (j == 0) { if (L < 3) cvt_list_pipelined<false>(L, ws, gw, ngw, (LAS unsigned*)cs, lane); }
            else if (i + 1 < 8 && i != 5) cvt_list_pipelined<true>(i + 1, ws, gw, ngw, (LAS unsigned*)cs, lane);
            if (j == 0) { if (L == 1) CVT_DSA_SMALL(); else if (L == 2) CVT_RWKV_SMALL(); else zero_bytes(ws + WS_WMLA + (size_t)(L ? 1 : 0) * SZ_MLA + (size_t)1600 * DM * 2, 192u * DM * 2, gtid, gthreads); } }
        PH_END(); ++ni;
        if (j == 1) continue;
        size_t wo_off;
        if (L == 0 || L == 3) {
            const int mb = L ? 44 : 6; const size_t wbo = WS_WMLA + (size_t)(L ? 1 : 0) * SZ_MLA; wo_off = wbo + SZ_MLA_IN + SZ_MLA_UQ + SZ_MLA_UKV;
            if (PH_ON()) PB(4) { PH_VARS unsigned long long* const rsqm = (unsigned long long*)(ws + CTL_RSQ) + (size_t)(N_RSQ + (rep_ ? 4 : (L ? 2 : 0))) * MT;
                EpiMlaIn E{(pg8::bf16_t*)(scr + ML_CQN), (pg8::bf16_t*)(scr + ML_LAT), T64, rsqc, rsqm};
                RUN_GEMM(EpiMlaIn, E, XH, ws + wbo, 1792, DM); }
            PH_END();
            if (PH_ON()) PB(6) { PH_VARS unsigned long long* const rsqm = (unsigned long long*)(ws + CTL_RSQ) + (size_t)(N_RSQ + (L ? 2 : 0)) * MT; EpiMlaQ E1{(pg8::bf16_t*)(scr + ML_Q), T64, rsqm}; RUN_GEMM_SK(EpiMlaQ, E1, scr + ML_CQN, ws + wbo + SZ_MLA_IN, 6144, 1024); }
            PH_END_NOBAR();
            if (PH_ON()) PB(20) { PH_VARS unsigned long long* const rsqm = (unsigned long long*)(ws + CTL_RSQ) + (size_t)(N_RSQ + (L ? 2 : 0)) * MT; EpiMlaKV E2{(pg8::bf16_t*)(scr + ML_K), (pg8::bf16_t*)(scr + ML_V), rsqm + MT, (const pg8::bf16_t*)(scr + ML_LAT)}; RUN_GEMM_SK(EpiMlaKV, E2, scr + ML_CKV, ws + wbo + SZ_MLA_IN + SZ_MLA_UQ, 8192, 512); }
            PH_END();
            if (PH_ON()) PB(7) { PH_VARS const float scale = 0.07216878364870322f;
                const bf16* Q = (const bf16*)(scr + ML_Q); const bf16* KF = (const bf16*)(scr + ML_K); const bf16* VB = (const bf16*)(scr + ML_V);
                for (int it = vcu; it < 1024; it += G) { int bh, qb; att::unit_of(it, bh, qb); const int b = bh >> 5, h = bh & 31; const size_t tok0 = (size_t)b * SEQ + 256 * qb, tokb = (size_t)b * SEQ;
                    att::attn_unit<192, 6144, 6144, 4096, false>(Q + tok0 * 6144 + h * 192, KF + tokb * 6144 + h * 192, VB + tokb * 4096 + h * 128, OB + tok0 * 4096 + h * 128,
                                                                 nullptr, qb, scale * 1.4426950408889634f, 8.0f / scale, (char*)lds, wave_s); } }
            PH_END();
        } else if (L == 1) {
            wo_off = WS_WDSA + SZ_DSA_IN + SZ_DSA_NAR;
            if (PH_ON()) PB(8) { PH_VARS EpiDsaIn E1{(pg8::bf16_t*)(scr + DS_Q), (pg8::bf16_t*)(scr + DS_K), (pg8::bf16_t*)(scr + DS_V), (pg8::bf16_t*)(scr + DS_QI), T64, T128, rsqc}; RUN_GEMM(EpiDsaIn, E1, XH, ws + WS_WDSA, 10240, DM); }
            PH_END_NOBAR();
            if (PH_ON()) PB(21) { PH_VARS EpiF32 E2{(float*)(scr + DS_KIW), 2048, rsqc};
                pg8::Gemm g_{(const pg8::bf16_t*)XH, (const pg8::bf16_t*)(ws + WS_WDSA + SZ_DSA_IN), MT, 2048, 512}; SplitKOrder S_; S_.G = G; S_.c = bx;
                pg8::gemm_phase<EpiF32, SplitKOrder, true, true>(ldsl, g_, S_, E2, wave_s); }
            PH_END();
            if (PH_ON()) PB(9) { PH_VARS phase_dsa_kiw((const float*)(scr + DS_KIW), T64, (bf16*)(scr + DS_KI), (float*)(scr + DS_WI), gw, ngw, lane); }
            PH_END();
            if (PH_ON()) PB(10) { PH_VARS phase_dsa_indexer((const bf16*)(scr + DS_QI), (const bf16*)(scr + DS_KI), (const float*)(scr + DS_WI), (float*)(scr + DS_SC), (LAS float*)ldsl, vcu, G, wave_s); }
            PH_END();
            if (PH_ON()) PB(11) { PH_VARS phase_dsa_topk((const float*)(scr + DS_SC), (unsigned*)(scr + DS_MASK), gw, ngw, lane); }
            PH_END();
            if (PH_ON()) PB(12) { PH_VARS const float scale = 0.08838834764831845f;
                const bf16* QD = (const bf16*)(scr + DS_Q); const bf16* KD = (const bf16*)(scr + DS_K); const bf16* VD = (const bf16*)(scr + DS_V); const unsigned* MASK = (const unsigned*)(scr + DS_MASK);
                for (int it = vcu; it < 1024; it += G) { int bh, qb; att::unit_of(it, bh, qb); const int b = bh >> 5, h = bh & 31; const size_t tok0 = (size_t)b * SEQ + 256 * qb, tokb = (size_t)b * SEQ;
                    att::attn_unit<128, 4096, 1024, 1024, true>(QD + tok0 * 4096 + h * 128, KD + tokb * 1024 + (h >> 2) * 128, VD + tokb * 1024 + (h >> 2) * 128, OB + tok0 * 4096 + h * 128,
                                                                MASK + tok0 * 64, qb, scale * 1.4426950408889634f, 8.0f / scale, (char*)lds, wave_s); } }
            PH_END();
        } else {
            wo_off = WS_WRW + RW_WO;
            constexpr size_t XS = (size_t)MT * DM;
            if (PH_ON()) PB(13) { PH_VARS phase_rwkv_mix(XH, XL, rsqc, INF(fb + 3), INF(22), (bf16*)(scr + RW_XR), gw, ngw, lane); }
            PH_END();
            if (PH_ON()) PB(14) { PH_VARS const bf16* XM = (const bf16*)(scr + RW_XR); const unsigned char* wb = ws + WS_WRW;
                static_assert(RW_K - RW_R == 128 * MiB && RW_V - RW_K == 128 * MiB, "r | k | v are equally spaced");
                for (int s = 0; s < 3; ++s) { EpiF32 E{(float*)(scr + RW_R + (size_t)s * (128 * MiB)), DM, nullptr}; RUN_GEMM(EpiF32, E, XM + (size_t)(s + (s > 0)) * XS, wb + (size_t)s * SZ_SQ, DM, DM); }
            }
            PH_END_NOBAR();
            if (PH_ON()) PB(22) { PH_VARS const bf16* XM = (const bf16*)(scr + RW_XR); const unsigned char* wb = ws + WS_WRW;
                { static_assert(RW_LA - RW_TW == 4 * MiB && RW_SG - RW_LA == 4 * MiB, "TW | LA | SG spacing"); EpiRwNarrow E{(pg8::bf16_t*)(scr + RW_TW)};
                  pg8::Gemm g_{(const pg8::bf16_t*)XM, (const pg8::bf16_t*)(wb + RW_W1), MT, 1024, DM}; JobOrder S_; S_.init(MT, 1024, G, bx); S_.a_stride = XS * 2; S_.a_sel = 0x5541u;
                  pg8::gemm_phase<EpiRwNarrow, JobOrder, true, true>(ldsl, g_, S_, E, wave_s); }
            }
            PH_END();
            if (PH_ON()) PB(15) { PH_VARS const unsigned char* wb = ws + WS_WRW;
                for (int s = 0; s < 3; ++s) { EpiRw2 E{(float*)(scr + (s == 0 ? RW_DEC : (s == 1 ? RW_AA : RW_G))), INF(s == 0 ? 27 : 30), s};
                    RUN_GEMM_SK(EpiRw2, E, scr + (s == 0 ? RW_TW : (s == 1 ? RW_LA : RW_SG)), wb + (s == 0 ? RW_W2 : (s == 1 ? RW_A2 : RW_G2)), DM, s == 2 ? 512 : 256); }
            }
            PH_END();
            if (PH_ON()) PB(17) { PH_VARS phase_rwkv_scan(scr, ws, INF(35), INF(36), INF(37), INF(38), INF(39), OB, (LAS float*)ldsl, vcu, G, wave_s); }
            PH_END();
        }
        if (PH_ON()) PB(18) { PH_VARS EpiResid E{(pg8::bf16_t*)XH, (pg8::bf16_t*)XL, rsqc + MT, rep_ ? 0.0f : 1.0f}; RUN_GEMM(EpiResid, E, OB, ws + wo_off, DM, DM);
            CVT_BEGIN if (L < 2) cvt_list_pipelined<true>(i + 1, ws, gw, ngw, (LAS unsigned*)cs, lane); (void)rot; }
        PH_END(); ++ni;
    }
    if (PH_ON()) PB(19) { PH_VARS phase_final_norm(XH, XL, rsqc, args.out + zo, INF(50), gw, ngw, lane); }
#undef CVT
#undef CVT_BEGIN
#undef CVT_FFN
#undef CVT_MLA
#undef CVT_DSA_SMALL
#undef CVT_RWKV_SMALL
#undef PH_ON
#undef PH_END
#undef RUN_GEMM
#undef PH_VARS
#undef INF
}

#ifndef PHASE_MASK
#define PHASE_MASK 0xFFFFFFFFu
#endif
constexpr unsigned THIN_BITS = (1u << 0) | (1u << 1) | (1u << 5) | (1u << 9) | (1u << 10) | (1u << 11) | (1u << 13) | (1u << 16) | (1u << 17) | (1u << 19);
#if MK_SPLIT
static int phase_bits(int* out) {
    int n = 0; out[n++] = 0;
    for (int i = 0; i < 8; ++i) { const int L = i >> 1, j = i & 1;
        out[n++] = 2; out[n++] = 3;
        if (j == 1) continue;
        if (L == 0 || L == 3) { const int b[] = {4, 5, 6, 20, 7}; for (int k = 0; k < 5; ++k) out[n++] = b[k]; }
        else if (L == 1) { const int b[] = {8, 21, 9, 10, 11, 12}; for (int k = 0; k < 6; ++k) out[n++] = b[k]; }
        else { const int b[] = {13, 14, 22, 15, 17}; for (int k = 0; k < 5; ++k) out[n++] = b[k]; }
        out[n++] = 18; }
    out[n++] = 19; return n;
}
#endif
#if MK_SPLIT
typedef void (*kern_t)(Args);
static kern_t kernel_for_bit(int bit) {
    if ((THIN_BITS >> bit) & 1u) return mega_fwd<THIN_BITS>;
    switch (bit) {
        case 2: return mega_fwd<1u << 2>; case 3: return mega_fwd<1u << 3>; case 4: return mega_fwd<1u << 4>; case 6: return mega_fwd<1u << 6>; case 20: return mega_fwd<1u << 20>;
        case 7: return mega_fwd<1u << 7>; case 8: return mega_fwd<1u << 8>; case 21: return mega_fwd<1u << 21>; case 12: return mega_fwd<1u << 12>; case 14: return mega_fwd<1u << 14>;
        case 15: return mega_fwd<1u << 15>; case 18: return mega_fwd<1u << 18>; case 22: return mega_fwd<1u << 22>; default: return nullptr; }
}
#endif
extern "C" void kernel_launch(void* const* d_in, const int* in_sizes, int n_in, void* d_out, int out_size, void* d_ws, size_t ws_size, hipStream_t stream) {
    static int grid = 0;
    if (grid == 0) {
        if (n_in != 51 || in_sizes[0] != MT * DM || out_size != MT * DM || ws_size < WS_END) {
            fprintf(stderr, "kernel_launch: unexpected shapes: n_in %d in0 %d out %d ws %zu (need %zu); nothing launched\n", n_in, n_in > 0 ? in_sizes[0] : -1, out_size, ws_size, (size_t)WS_END); grid = -1; return; }
        int dev = 0, cus = 0;
        if (hipGetDevice(&dev) != hipSuccess || hipDeviceGetAttribute(&cus, hipDeviceAttributeMultiprocessorCount, dev) != hipSuccess) { grid = -1; return; }
#if MK_SPLIT
        for (int bit = 0; bit < 23; ++bit) { kern_t k = kernel_for_bit(bit); if (k && hipFuncSetAttribute((const void*)k, hipFuncAttributeMaxDynamicSharedMemorySize, LDS_BYTES) != hipSuccess) { fprintf(stderr, "kernel_launch: hipFuncSetAttribute failed (bit %d)\n", bit); grid = -1; return; } }
#else
        if (hipFuncSetAttribute((const void*)mega_fwd<PHASE_MASK>, hipFuncAttributeMaxDynamicSharedMemorySize, LDS_BYTES) != hipSuccess) { fprintf(stderr, "kernel_launch: hipFuncSetAttribute failed\n"); grid = -1; return; }
#endif
        (void)hipGetLastError();
        grid = cus;
    }
    if (grid < 0) return;
    (void)hipMemsetAsync((char*)d_ws + WS_CTL, 0, CTL_BYTES, stream);
    Args a{};
    for (int i = 0; i < 51; ++i) a.in[i] = d_in[i];
    a.out = (float*)d_out; a.ws = (unsigned char*)d_ws;
#if MK_SPLIT
    int bits[80]; const int np = phase_bits(bits);
    for (int p = 0; p < np; ++p) { a.ph_lo = p; a.ph_hi = p + 1; kern_t k = kernel_for_bit(bits[p]); hipLaunchKernelGGL(k, dim3(grid), dim3(NTHR), LDS_BYTES, stream, a); }
#else
    a.ph_lo = 0; a.ph_hi = 1 << 30;
    hipLaunchKernelGGL(mega_fwd<PHASE_MASK>, dim3(grid), dim3(NTHR), LDS_BYTES, stream, a);
#endif
    const hipError_t le = hipPeekAtLastError();
    if (le != hipSuccess) fprintf(stderr, "kernel_launch: launch failed: %s\n", hipGetErrorName(le));
}
```
